# Optimizing an MI355X kernel written in HIP

```python
import jax, jax.numpy as jnp
from jax import lax
import numpy as np

D_MODEL = 1024
BATCH = 8
SEQ = 2048
DEPTH = 4

N_MIXERS = 2
N_RG = (DEPTH + 1) // 2
N_HG = DEPTH // 2
LRU_WIDTH = D_MODEL
RG_HEADS = 8
RG_BLOCK = LRU_WIDTH // RG_HEADS
CONV_WIDTH = 4
LRU_C = 8.0
HG_HEADS = 8
HG_DK = D_MODEL // HG_HEADS
HG_DV = D_MODEL // HG_HEADS
HG_CHUNK = 64
D_FF = 4 * D_MODEL
NORM_EPS = 1e-6
GNORM_EPS = 1e-5

kernel_name = "hybrid_rglru_hgrn2_adaln_trunk"


def rms_norm(x, gain, eps=NORM_EPS):
    xf = x.astype(jnp.float32)
    y = xf * lax.rsqrt(jnp.mean(xf * xf, axis=-1, keepdims=True) + eps)
    return (y * gain.astype(jnp.float32)).astype(x.dtype)


def causal_depthwise_conv(x, w, b):
    T = x.shape[1]
    xp = jnp.pad(x, ((0, 0), (CONV_WIDTH - 1, 0), (0, 0)))
    y = b
    for tap in range(CONV_WIDTH):
        y = y + xp[:, tap:tap + T, :] * w[tap]
    return y


def rg_lru(x, w_a, b_a, w_x, b_x, lam):
    B, T, _ = x.shape
    xh = x.reshape(B, T, RG_HEADS, RG_BLOCK)
    r = jax.nn.sigmoid(jnp.einsum('bthi,hij->bthj', xh, w_a).reshape(B, T, LRU_WIDTH) + b_a)
    i = jax.nn.sigmoid(jnp.einsum('bthi,hij->bthj', xh, w_x).reshape(B, T, LRU_WIDTH) + b_x)
    log_a = -LRU_C * r.astype(jnp.float32) * jax.nn.softplus(-lam.astype(jnp.float32))
    a = jnp.exp(log_a)
    mult = jnp.sqrt(-jnp.expm1(2.0 * log_a))
    mult = jnp.where(jnp.arange(T)[None, :, None] == 0, 1.0, mult)
    u = mult * (i * x).astype(jnp.float32)

    def combine(left, right):
        a1, b1 = left
        a2, b2 = right
        return a1 * a2, a2 * b1 + b2

    _, h = lax.associative_scan(combine, (a, u), axis=1)
    return h.astype(x.dtype)


def rglru_block(h, w_in, conv_w, conv_b, w_a, b_a, w_x, b_x, lam, w_out):
    xb, yb = jnp.split(h @ w_in, 2, axis=-1)
    gate = jax.nn.gelu(yb, approximate=True)
    xb = causal_depthwise_conv(xb, conv_w, conv_b)
    hr = rg_lru(xb, w_a, b_a, w_x, b_x, lam)
    return (hr * gate) @ w_out


def hgrn2_chunk_scan(q, k, v, log_f):
    B, T, H, _ = q.shape
    N = T // HG_CHUNK

    def to_chunks(t):
        return t.astype(jnp.float32).reshape(B, N, HG_CHUNK, H, -1).transpose(1, 0, 3, 2, 4)

    qc, kc, vc, lc = to_chunks(q), to_chunks(k), to_chunks(v), to_chunks(log_f)
    bc = jnp.cumsum(lc, axis=3)
    causal = jnp.tril(jnp.ones((HG_CHUNK, HG_CHUNK), dtype=bool))

    def step(S, inp):
        q_, k_, v_, b_ = inp
        diff = b_[:, :, :, None, :] - b_[:, :, None, :, :]
        decay = jnp.exp(jnp.where(causal[:, :, None], diff, -jnp.inf))
        A = jnp.einsum('bhtsk,bhsk->bhts', q_[:, :, :, None, :] * decay, k_)
        o = A @ v_ + jnp.einsum('bhtk,bhkv->bhtv', q_ * jnp.exp(b_), S)
        b_last = b_[:, :, -1:, :]
        S = jnp.exp(b_last)[:, :, 0, :, None] * S + jnp.einsum(
            'bhsk,bhsv->bhkv', k_ * jnp.exp(b_last - b_), v_)
        return S, o

    S0 = jnp.zeros((B, H, HG_DK, HG_DV), jnp.float32)
    _, o = lax.scan(step, S0, (qc, kc, vc, bc))
    return o.transpose(1, 0, 3, 2, 4).reshape(B, T, H, HG_DV)


def hgrn2_block(h, w_in, lb, gnorm_w, w_out):
    B, T, _ = h.shape
    q, f, i, g = jnp.split(h @ w_in, 4, axis=-1)
    q = jax.nn.silu(q)
    fg = lb + (1.0 - lb) * jax.nn.sigmoid(f.astype(jnp.float32))
    log_f = jnp.log(fg)
    k = 1.0 - fg

    def heads(t):
        return t.reshape(B, T, HG_HEADS, -1)

    o = hgrn2_chunk_scan(heads(q), heads(k), heads(i), heads(log_f))
    o = rms_norm(o, gnorm_w, GNORM_EPS) * jax.nn.silu(heads(g).astype(jnp.float32))
    return (o.reshape(B, T, D_MODEL) @ w_out).astype(h.dtype)


def setup_inputs(seed: int = 0) -> dict:
    key = jax.random.key(seed)
    ks = jax.random.split(key, 24)
    f32 = jnp.float32
    nrm = lambda k, shape, s: jax.random.normal(k, shape, f32) * s
    u = jax.random.uniform(ks[11], (N_RG, LRU_WIDTH), f32, 0.9, 0.999)
    s = u ** (1.0 / LRU_C)
    lam = jnp.log(s) - jnp.log1p(-s)
    return {
        "x": nrm(ks[0], (BATCH, SEQ, D_MODEL), 1.0),
        "c": nrm(ks[1], (BATCH, D_MODEL), 1.0),
        "mod_w": nrm(ks[2], (DEPTH, D_MODEL, 6 * D_MODEL), D_MODEL ** -0.5),
        "mod_b": nrm(ks[3], (DEPTH, 6 * D_MODEL), 0.02),
        "norm_mix": 1.0 + nrm(ks[4], (DEPTH, D_MODEL), 0.02),
        "norm_mlp": 1.0 + nrm(ks[5], (DEPTH, D_MODEL), 0.02),
        "norm_final": 1.0 + nrm(ks[6], (D_MODEL,), 0.02),
        "rg_w_in": nrm(ks[7], (N_RG, D_MODEL, 2 * LRU_WIDTH), D_MODEL ** -0.5),
        "rg_conv_w": nrm(ks[8], (N_RG, CONV_WIDTH, LRU_WIDTH), CONV_WIDTH ** -0.5),
        "rg_conv_b": nrm(ks[9], (N_RG, LRU_WIDTH), 0.02),
        "rg_w_a": nrm(ks[10], (N_RG, RG_HEADS, RG_BLOCK, RG_BLOCK), RG_BLOCK ** -0.5),
        "rg_b_a": nrm(ks[12], (N_RG, LRU_WIDTH), 0.1),
        "rg_w_x": nrm(ks[13], (N_RG, RG_HEADS, RG_BLOCK, RG_BLOCK), RG_BLOCK ** -0.5),
        "rg_b_x": nrm(ks[14], (N_RG, LRU_WIDTH), 0.1),
        "rg_lambda": lam,
        "rg_w_out": nrm(ks[15], (N_RG, LRU_WIDTH, D_MODEL), LRU_WIDTH ** -0.5),
        "hg_w_in": nrm(ks[16], (N_HG, D_MODEL, 4 * D_MODEL), D_MODEL ** -0.5),
        "hg_lower_bounds": nrm(ks[17], (DEPTH, D_MODEL), 0.1),
        "hg_gnorm": 1.0 + nrm(ks[18], (N_HG, HG_DV), 0.02),
        "hg_w_out": nrm(ks[19], (N_HG, D_MODEL, D_MODEL), D_MODEL ** -0.5),
        "mlp_w1": nrm(ks[20], (DEPTH, D_MODEL, D_FF), D_MODEL ** -0.5),
        "mlp_w2": nrm(ks[21], (DEPTH, D_FF, D_MODEL), D_FF ** -0.5),
    }


def reference(x, c, mod_w, mod_b, norm_mix, norm_mlp, norm_final,
              rg_w_in, rg_conv_w, rg_conv_b, rg_w_a, rg_b_a, rg_w_x, rg_b_x, rg_lambda, rg_w_out,
              hg_w_in, hg_lower_bounds, hg_gnorm, hg_w_out, mlp_w1, mlp_w2):
    cs = jax.nn.silu(c)
    lb_all = jnp.cumsum(jax.nn.softmax(hg_lower_bounds.astype(jnp.float32), axis=0), axis=0)
    lb_all = lb_all - lb_all[0]
    for layer in range(DEPTH):
        mod = cs @ mod_w[layer] + mod_b[layer]
        sh_t, sc_t, g_t, sh_c, sc_c, g_c = [m[:, None, :] for m in jnp.split(mod, 6, axis=-1)]
        h = rms_norm(x, norm_mix[layer]) * (1.0 + sc_t) + sh_t
        j = layer // N_MIXERS
        if layer % N_MIXERS == 0:
            y = rglru_block(h, rg_w_in[j], rg_conv_w[j], rg_conv_b[j], rg_w_a[j], rg_b_a[j],
                            rg_w_x[j], rg_b_x[j], rg_lambda[j], rg_w_out[j])
        else:
            y = hgrn2_block(h, hg_w_in[j], lb_all[layer], hg_gnorm[j], hg_w_out[j])
        x = (x + g_t * y).astype(x.dtype)
        h = rms_norm(x, norm_mlp[layer]) * (1.0 + sc_c) + sh_c
        ff = jnp.square(jax.nn.relu(h @ mlp_w1[layer])) @ mlp_w2[layer]
        x = (x + g_c * ff).astype(x.dtype)
    return rms_norm(x, norm_final)
```

```cpp
#include <hip/hip_runtime.h>
#include <hip/hip_cooperative_groups.h>
#include <cstdio>
#include <cstdint>
namespace cg = cooperative_groups;

#define LAS __attribute__((address_space(3)))
typedef unsigned short bf16_t;
typedef short bf16x8 __attribute__((ext_vector_type(8)));
typedef float f32x4 __attribute__((ext_vector_type(4)));
typedef float f32x2 __attribute__((ext_vector_type(2)));
typedef unsigned u32x4 __attribute__((ext_vector_type(4)));
typedef unsigned u32x2 __attribute__((ext_vector_type(2)));

constexpr int NB = 8, T = 2048, D = 1024, M = NB * T, FF = 4096, DEPTH = 4;
constexpr int MODW = 6 * D;
constexpr float NORM_EPS = 1e-6f, GNORM_EPS = 1e-5f;

constexpr size_t MiB = 1u << 20;
constexpr size_t WS_MOD = 1 * MiB;
constexpr size_t WS_LB = WS_MOD + 768 * 1024;
constexpr size_t WS_W = 2 * MiB;
constexpr size_t W_RGIN = WS_W + 0 * MiB, W_RGOUT = WS_W + 8 * MiB, W_RGAX = WS_W + 12 * MiB, W_HGIN = WS_W + 13 * MiB, W_HGOUT = WS_W + 29 * MiB,
                 W_W1 = WS_W + 33 * MiB, W_W2 = WS_W + 65 * MiB;
constexpr size_t WS_A1 = 100 * MiB;
constexpr size_t WS_A2 = 132 * MiB;
constexpr size_t WS_BIG = 164 * MiB;
constexpr size_t WS_SS = 292 * MiB;
constexpr size_t WS_SHW = 293 * MiB;
constexpr size_t WS_END = 294 * MiB;

constexpr int LDS_BYTES = 147456;

#define LBAR() do { asm volatile("s_waitcnt lgkmcnt(0)" ::: "memory"); __builtin_amdgcn_s_barrier(); asm volatile("" ::: "memory"); } while (0)
typedef __bf16 bf16x2_t __attribute__((ext_vector_type(2)));
__device__ __forceinline__ unsigned cvt_pk_bf16(float lo, float hi) { f32x2 v = {lo, hi}; bf16x2_t b = __builtin_convertvector(v, bf16x2_t); return __builtin_bit_cast(unsigned, b); }
__device__ __forceinline__ void st16_wt(void* p, u32x4 v) { *(u32x4*)p = v; }
__device__ __forceinline__ void st16_wt(void* p, f32x4 v) { *(f32x4*)p = v; }
__device__ __forceinline__ float bf_lo(unsigned w) { return __builtin_bit_cast(float, w << 16); }
__device__ __forceinline__ float bf_hi(unsigned w) { return __builtin_bit_cast(float, w & 0xffff0000u); }
__device__ __forceinline__ float bf1(bf16_t v) { return __builtin_bit_cast(float, (unsigned)v << 16); }
__device__ __forceinline__ unsigned pk_f16(float lo, float hi) { typedef _Float16 h2 __attribute__((ext_vector_type(2))); h2 v; v.x = (_Float16)lo; v.y = (_Float16)hi; return __builtin_bit_cast(unsigned, v); }
__device__ __forceinline__ float h_lo(unsigned w) { typedef _Float16 h2 __attribute__((ext_vector_type(2))); h2 v = __builtin_bit_cast(h2, w); return (float)v.x; }
__device__ __forceinline__ float h_hi(unsigned w) { typedef _Float16 h2 __attribute__((ext_vector_type(2))); h2 v = __builtin_bit_cast(h2, w); return (float)v.y; }
__device__ __forceinline__ float fexp(float x) { return __builtin_amdgcn_exp2f(x * 1.4426950408889634f); }
__device__ __forceinline__ float fsigmoid(float x) { return __builtin_amdgcn_rcpf(1.0f + __builtin_amdgcn_exp2f(x * -1.4426950408889634f)); }
__device__ __forceinline__ int opaque_tid(int wv) { int t; asm volatile("v_mbcnt_lo_u32_b32 %0, -1, 0\n\tv_mbcnt_hi_u32_b32 %0, -1, %0" : "=v"(t)); return (wv << 6) + t; }
__device__ __forceinline__ float wave_sum(float v) {
#pragma unroll
    for (int o = 1; o < 64; o <<= 1) v += __shfl_xor(v, o);
    return v;
}

namespace pg8 {
#define PG8_LAS __attribute__((address_space(3)))
constexpr int BM = 256, BK = 64, HALF = 128, HTB = HALF * BK * 2, STAGE_BYTES = 8 * HTB, NXCD = 8, WGM = 8;
__host__ __device__ __forceinline__ int lds_byte(int r, int c) { const int st = (r >> 4) * 2 + (c >> 5), rr = r & 15, cc = c & 31, ob = rr * 64 + cc * 2; return st * 1024 + (ob ^ (((ob >> 9) & 1) << 5)); }
__host__ __device__ __forceinline__ void stage_rc(int b, int& R, int& C) { const int st = b / 1024, sb = b % 1024, swz = sb ^ (((sb >> 9) & 1) << 5); R = (st >> 1) * 16 + swz / 64; C = (st & 1) * 32 + (swz % 64) / 2; }
__host__ __device__ __forceinline__ int perm32(int rho) { const int n = rho >> 4, i = rho & 15; return 8 * (i >> 2) + 4 * n + (i & 3); }

struct Unit { int pm, pn, idx; };
struct Gemm { const bf16_t* A; const bf16_t* Bt; int M, N, K; };
struct StaticOrder {
    int nM, nN, nwg, G, c;
    __host__ __device__ void init(int M_, int N_, int G_, int c_) { nM = M_ / BM; nN = N_ / BM; nwg = nM * nN; G = G_; c = c_; }
    __host__ __device__ bool next(int i, Unit& u) const {
        const long L = (long)i * G + c; if (L >= nwg) return false;
        int wgid = (int)L; { const int q = nwg / NXCD, r = nwg % NXCD, xcd = wgid % NXCD, off = wgid / NXCD; wgid = (xcd < r ? xcd * (q + 1) : r * (q + 1) + (xcd - r) * q) + off; }
        const int nig = WGM * nN, gid = wgid / nig, fm = gid * WGM, gsz = (nM - fm) < WGM ? (nM - fm) : WGM;
        u.pm = fm + ((wgid % nig) % gsz); u.pn = (wgid % nig) / gsz; u.idx = i; return true;
    }
    __device__ __forceinline__ void a_ready(const Unit&) const {}
    __device__ __forceinline__ void done(const Unit&) const {}
};

template <int MODE> struct EpiAct {
    static constexpr bool PERM = true, AFTER_DRAIN = false;
    bf16_t* O; int ldc; const float* lb; PG8_LAS unsigned char* tab;
    __device__ __forceinline__ void operator()(const f32x4 (&acc)[2][2][4][2], const Unit& u, int wr, int wc, int fr, int fq) const {
        const int row0 = u.pm * BM + wr * 64 + fr; const int colt = u.pn * BM; const int blk = colt >> 10;
        const int col0 = colt + wc * 32 + 8 * fq;
        float rsv[8];
        { PG8_LAS const float* rt = (PG8_LAS const float*)(tab + u.idx * 2048) + wr * 64 + fr;
#pragma unroll
            for (int i = 0; i < 8; ++i) rsv[i] = rt[(i >> 2) * HALF + (i & 3) * 16]; }
        f32x4 sw[2][2];
        { PG8_LAS const float* st = (PG8_LAS const float*)(tab + u.idx * 2048 + 1024) + wc * 32 + 8 * fq;
#pragma unroll
            for (int bj = 0; bj < 2; ++bj)
#pragma unroll
                for (int n = 0; n < 2; ++n) sw[bj][n] = *(PG8_LAS const f32x4*)(st + bj * HALF + 4 * n); }
        f32x4 om[2][2];
        if (MODE == 1) {
#pragma unroll
            for (int bj = 0; bj < 2; ++bj)
#pragma unroll
                for (int n = 0; n < 2; ++n) { om[bj][n] = (f32x4){0.f, 0.f, 0.f, 0.f};
                    if (blk == 1) { const f32x4 l = *(const f32x4*)(lb + (col0 - 1024) + bj * HALF + 4 * n); om[bj][n] = 1.0f - l; } }
        }
#pragma unroll
        for (int ai = 0; ai < 2; ++ai)
#pragma unroll
            for (int m = 0; m < 4; ++m) { bf16_t* rowp = O + (size_t)(row0 + ai * HALF + m * 16) * ldc + col0;
#pragma unroll
                for (int bj = 0; bj < 2; ++bj) { f32x4 v[2] = {acc[ai][bj][m][0] * rsv[ai * 4 + m] + sw[bj][0], acc[ai][bj][m][1] * rsv[ai * 4 + m] + sw[bj][1]}; u32x4 w;
                    if (MODE == 0) {
                        if (blk == 1) {
#pragma unroll
                            for (int n = 0; n < 2; ++n)
#pragma unroll
                                for (int e = 0; e < 4; ++e) { const float x = v[n][e]; const float z = 1.5957691216f * (x + 0.044715f * x * x * x); v[n][e] = x * fsigmoid(z); }
                        }
                        w.x = cvt_pk_bf16(v[0][0], v[0][1]); w.y = cvt_pk_bf16(v[0][2], v[0][3]); w.z = cvt_pk_bf16(v[1][0], v[1][1]); w.w = cvt_pk_bf16(v[1][2], v[1][3]);
                    } else if (MODE == 1) {
                        if (blk == 1) {
#pragma unroll
                            for (int n = 0; n < 2; ++n)
#pragma unroll
                                for (int e = 0; e < 4; ++e) v[n][e] = om[bj][n][e] * fsigmoid(-v[n][e]);
                            w.x = pk_f16(v[0][0], v[0][1]); w.y = pk_f16(v[0][2], v[0][3]); w.z = pk_f16(v[1][0], v[1][1]); w.w = pk_f16(v[1][2], v[1][3]);
                        } else {
                            if (blk != 2) {
#pragma unroll
                                for (int n = 0; n < 2; ++n)
#pragma unroll
                                    for (int e = 0; e < 4; ++e) v[n][e] = v[n][e] * fsigmoid(v[n][e]);
                            }
                            w.x = cvt_pk_bf16(v[0][0], v[0][1]); w.y = cvt_pk_bf16(v[0][2], v[0][3]); w.z = cvt_pk_bf16(v[1][0], v[1][1]); w.w = cvt_pk_bf16(v[1][2], v[1][3]);
                        }
                    } else {
#pragma unroll
                        for (int n = 0; n < 2; ++n)
#pragma unroll
                            for (int e = 0; e < 4; ++e) { const float x = fmaxf(v[n][e], 0.f); v[n][e] = x * x; }
                        w.x = cvt_pk_bf16(v[0][0], v[0][1]); w.y = cvt_pk_bf16(v[0][2], v[0][3]); w.z = cvt_pk_bf16(v[1][0], v[1][1]); w.w = cvt_pk_bf16(v[1][2], v[1][3]);
                    }
                    st16_wt(rowp + bj * HALF, w); } }
    }
};
struct EpiRes {
    static constexpr bool PERM = true, AFTER_DRAIN = false;
    const float* xin; float* xout; const float* gate;
    bf16_t* a1; const float* gain; const float* sc; float* ss;
    __device__ __forceinline__ void operator()(const f32x4 (&acc)[2][2][4][2], const Unit& u, int wr, int wc, int fr, int fq) const {
        const int b = (u.pm * BM) / T; const int col0 = u.pn * BM + wc * 32 + 8 * fq;
        f32x4 gv[2][2], gn[2][2];
#pragma unroll
        for (int bj = 0; bj < 2; ++bj)
#pragma unroll
            for (int n = 0; n < 2; ++n) { gv[bj][n] = *(const f32x4*)(gate + (size_t)b * MODW + col0 + bj * HALF + n * 4);
                if (a1) { const f32x4 g0 = *(const f32x4*)(gain + col0 + bj * HALF + n * 4), s0 = *(const f32x4*)(sc + (size_t)b * MODW + col0 + bj * HALF + n * 4); gn[bj][n] = g0 * (1.0f + s0); } }
#pragma unroll
        for (int ai = 0; ai < 2; ++ai)
#pragma unroll
            for (int m = 0; m < 4; ++m) { const int row = u.pm * BM + ai * HALF + wr * 64 + m * 16 + fr; const size_t off = (size_t)row * D + col0; float sq = 0.f;
#pragma unroll
                for (int bj = 0; bj < 2; ++bj) { f32x4 xn[2];
#pragma unroll
                    for (int n = 0; n < 2; ++n) { const f32x4 xi = *(const f32x4*)(xin + off + bj * HALF + n * 4); xn[n] = xi + gv[bj][n] * acc[ai][bj][m][n]; }
                    st16_wt(xout + off + bj * HALF, xn[0]); st16_wt(xout + off + bj * HALF + 4, xn[1]);
                    if (a1) { sq += ((xn[0][0] * xn[0][0] + xn[0][1] * xn[0][1]) + (xn[0][2] * xn[0][2] + xn[0][3] * xn[0][3])) + ((xn[1][0] * xn[1][0] + xn[1][1] * xn[1][1]) + (xn[1][2] * xn[1][2] + xn[1][3] * xn[1][3]));
                        const f32x4 y0 = xn[0] * gn[bj][0], y1 = xn[1] * gn[bj][1];
                        st16_wt(a1 + off + bj * HALF, (u32x4){cvt_pk_bf16(y0[0], y0[1]), cvt_pk_bf16(y0[2], y0[3]), cvt_pk_bf16(y1[0], y1[1]), cvt_pk_bf16(y1[2], y1[3])}); } }
                if (a1) { sq += __shfl_xor(sq, 16); sq += __shfl_xor(sq, 32); if (fq == 0) ss[(size_t)row * 16 + u.pn * 4 + wc] = sq; }
                if (m & 1) asm volatile("" ::: "memory"); }
    }
};

template <class Sched>
__device__ __forceinline__ void stage_unit_tables(PG8_LAS unsigned char* tab, const Sched& S, const float* ss, const float* shw, int wv) {
    const int tid = opaque_tid(wv);
    Unit u;
    for (int i = 0; S.next(i, u); ++i) {
        PG8_LAS float* t = (PG8_LAS float*)(tab + i * 2048);
        if (tid < 256) { const f32x4* sp = (const f32x4*)(ss + (size_t)(u.pm * BM + tid) * 16); const f32x4 sm = (sp[0] + sp[1]) + (sp[2] + sp[3]);
            t[tid] = rsqrtf(((sm[0] + sm[1]) + (sm[2] + sm[3])) * (1.0f / D) + NORM_EPS); }
        else t[tid] = shw[(size_t)((u.pm * BM) / T) * 4096 + u.pn * BM + (tid - 256)];
    }
    asm volatile("s_waitcnt vmcnt(0) lgkmcnt(0)" ::: "memory"); __builtin_amdgcn_s_barrier(); asm volatile("" ::: "memory");
}

template <class Epi, class Sched, bool ALIGN_EPI = false, bool SP2 = false>
__device__ __forceinline__ void gemm_phase(PG8_LAS unsigned char* lds, const Gemm g, const Sched& S, const Epi& E, int wv) {
    const int tid = opaque_tid(wv), wid = __builtin_amdgcn_readfirstlane(tid >> 6), lane = tid & 63, wr = wid >> 2, wc = wid & 3, fr = lane & 15, fq = lane >> 4;
    const int K = g.K, nt = K / BK;
    unsigned voffA[2], voffB[2];
#pragma unroll
    for (int i = 0; i < 2; ++i) { int R, C; stage_rc(tid * 16 + i * 8192, R, C); const int Rb = Epi::PERM ? ((R & ~31) + perm32(R & 31)) : R;
        voffA[i] = (unsigned)(R * K + C) * 2u; voffB[i] = (unsigned)(Rb * K + C) * 2u; }
    const size_t kstep = (size_t)(BK * 2);
    const size_t hstep = (size_t)HALF * K * 2;
    const size_t tstep = 2 * hstep;
    const unsigned ldsw = (unsigned)wid * 1024u;
    const int aoff = lds_byte(wr * 64 + fr, fq * 8), boff = lds_byte(wc * 32 + fr, fq * 8);
#define PG8_SA(b, h) (((b) * 2 + (h)) * HTB)
#define PG8_SB(b, h) ((4 + (b) * 2 + (h)) * HTB)
#define PG8_STAGE(bufoff, gbase, voff) do { _Pragma("unroll") for (int _i = 0; _i < 2; ++_i) \
        __builtin_amdgcn_global_load_lds((const unsigned*)((const char*)(gbase) + (voff)[_i]), (PG8_LAS unsigned*)(lds + (bufoff) + ldsw + _i * 8192), 16, 0, 0); } while (0)
#define PG8_LDA(dst, b, h) do { _Pragma("unroll") for (int m = 0; m < 4; ++m) _Pragma("unroll") for (int k = 0; k < 2; ++k) dst[m][k] = *(const PG8_LAS bf16x8*)(lds + PG8_SA(b, h) + aoff + m * 2048 + k * 1024); } while (0)
#define PG8_LDB(dst, b, h) do { _Pragma("unroll") for (int n = 0; n < 2; ++n) _Pragma("unroll") for (int k = 0; k < 2; ++k) dst[n][k] = *(const PG8_LAS bf16x8*)(lds + PG8_SB(b, h) + boff + n * 2048 + k * 1024); } while (0)
#define PG8_MMA(ai, bj, At, Bt) do { __builtin_amdgcn_s_setprio(1); _Pragma("unroll") for (int m = 0; m < 4; ++m) _Pragma("unroll") for (int n = 0; n < 2; ++n) _Pragma("unroll") for (int k = 0; k < 2; ++k) \
        acc[ai][bj][m][n] = __builtin_amdgcn_mfma_f32_16x16x32_bf16(Bt[n][k], At[m][k], acc[ai][bj][m][n], 0, 0, 0); __builtin_amdgcn_s_setprio(0); } while (0)
#define PG8_WAIT_V(n) asm volatile("s_waitcnt vmcnt(" #n ")" ::: "memory")
#define PG8_WAIT_L(n) asm volatile("s_waitcnt lgkmcnt(" #n ")" ::: "memory")
#define PG8_BAR __builtin_amdgcn_s_barrier()
#define PG8_SCHED __builtin_amdgcn_sched_barrier(0)
    Unit cur, nxt; int ui = 0;
    if (!S.next(0, cur)) return;
    f32x4 acc[2][2][4][2];
#pragma unroll
    for (int a = 0; a < 2; ++a)
#pragma unroll
        for (int b = 0; b < 2; ++b)
#pragma unroll
            for (int m = 0; m < 4; ++m)
#pragma unroll
                for (int n = 0; n < 2; ++n) acc[a][b][m][n] = (f32x4){0.f, 0.f, 0.f, 0.f};
    bf16x8 At[4][2], B0[2][2], B1[2][2];
    const char* cA = (const char*)g.A + (size_t)cur.pm * tstep; const char* cB = (const char*)g.Bt + (size_t)cur.pn * tstep;
    S.a_ready(cur);
    if constexpr (SP2) {
        PG8_STAGE(PG8_SB(0, 0), cB, voffB); PG8_STAGE(PG8_SB(0, 1), cB + hstep, voffB); PG8_STAGE(PG8_SA(0, 0), cA, voffA); PG8_STAGE(PG8_SA(0, 1), cA + hstep, voffA);
        if (wr == 1) PG8_BAR;
        PG8_WAIT_V(2); PG8_BAR;
        PG8_STAGE(PG8_SB(1, 0), cB + kstep, voffB); PG8_STAGE(PG8_SA(1, 0), cA + kstep, voffA); PG8_STAGE(PG8_SB(1, 1), cB + hstep + kstep, voffB);
        PG8_WAIT_V(6); PG8_BAR;
    } else {
        PG8_STAGE(PG8_SB(0, 0), cB, voffB); PG8_STAGE(PG8_SA(0, 0), cA, voffA); PG8_STAGE(PG8_SB(0, 1), cB + hstep, voffB); PG8_STAGE(PG8_SA(0, 1), cA + hstep, voffA);
        if (wr == 1) PG8_BAR;
        PG8_WAIT_V(4); PG8_BAR;
        PG8_STAGE(PG8_SB(1, 0), cB + kstep, voffB); PG8_STAGE(PG8_SA(1, 0), cA + kstep, voffA); PG8_STAGE(PG8_SB(1, 1), cB + hstep + kstep, voffB);
        PG8_WAIT_V(6); PG8_BAR;
    }
    for (;;) {
        const bool has_next = S.next(ui + 1, nxt);
        const char* nA = has_next ? (const char*)g.A + (size_t)nxt.pm * tstep : cA; const char* nB = has_next ? (const char*)g.Bt + (size_t)nxt.pn * tstep : cB;
        for (int t = 0; t < nt; t += 2) {
            const bool last = (t == nt - 2);
            const char* a1 = cA + (size_t)(t + 1) * kstep;
            const char* a2 = last ? nA : cA + (size_t)(t + 2) * kstep; const char* b2 = last ? nB : cB + (size_t)(t + 2) * kstep;
            const char* a3 = a2 + kstep; const char* b3 = b2 + kstep;
            if (last && has_next) S.a_ready(nxt);
            if constexpr (SP2) {
            PG8_LDB(B0, 0, 0); PG8_LDB(B1, 0, 1); PG8_SCHED; PG8_LDA(At, 0, 0); PG8_STAGE(PG8_SA(1, 1), a1 + hstep, voffA);
            PG8_WAIT_V(8); PG8_WAIT_L(0); PG8_BAR; PG8_MMA(0, 0, At, B0); PG8_MMA(0, 1, At, B1); PG8_BAR; PG8_SCHED;
            PG8_LDA(At, 0, 1); PG8_STAGE(PG8_SB(0, 0), b2, voffB); PG8_STAGE(PG8_SB(0, 1), b2 + hstep, voffB); PG8_STAGE(PG8_SA(0, 0), a2, voffA);
            PG8_WAIT_V(8); PG8_WAIT_L(0); PG8_BAR; PG8_MMA(1, 0, At, B0); PG8_MMA(1, 1, At, B1); PG8_BAR; PG8_SCHED;
            PG8_LDB(B0, 1, 0); PG8_LDB(B1, 1, 1); PG8_SCHED; PG8_LDA(At, 1, 0); PG8_STAGE(PG8_SA(0, 1), a2 + hstep, voffA);
            PG8_WAIT_V(8); PG8_WAIT_L(0); PG8_BAR; PG8_MMA(0, 0, At, B0); PG8_MMA(0, 1, At, B1); PG8_BAR; PG8_SCHED;
            PG8_LDA(At, 1, 1); PG8_STAGE(PG8_SB(1, 0), b3, voffB); PG8_STAGE(PG8_SB(1, 1), b3 + hstep, voffB); PG8_STAGE(PG8_SA(1, 0), a3, voffA);
            PG8_WAIT_V(8); PG8_WAIT_L(0); PG8_BAR; PG8_MMA(1, 0, At, B0); PG8_MMA(1, 1, At, B1); PG8_BAR; PG8_SCHED;
            } else {
            PG8_LDB(B0, 0, 0); PG8_SCHED; PG8_LDA(At, 0, 0); PG8_STAGE(PG8_SA(1, 1), a1 + hstep, voffA);
            PG8_WAIT_L(8); PG8_BAR; PG8_WAIT_L(0); PG8_MMA(0, 0, At, B0); PG8_BAR; PG8_SCHED;
            PG8_LDB(B1, 0, 1); PG8_STAGE(PG8_SB(0, 0), b2, voffB);
            PG8_BAR; PG8_WAIT_L(0); PG8_MMA(0, 1, At, B1); PG8_BAR;
            PG8_LDA(At, 0, 1); PG8_STAGE(PG8_SA(0, 0), a2, voffA);
            PG8_BAR; PG8_WAIT_L(0); PG8_MMA(1, 0, At, B0); PG8_BAR; PG8_SCHED;
            PG8_STAGE(PG8_SB(0, 1), b2 + hstep, voffB);
            PG8_WAIT_V(6); PG8_BAR; PG8_MMA(1, 1, At, B1); PG8_BAR;
            PG8_LDB(B0, 1, 0); PG8_SCHED; PG8_LDA(At, 1, 0); PG8_STAGE(PG8_SA(0, 1), a2 + hstep, voffA);
            PG8_WAIT_L(8); PG8_BAR; PG8_WAIT_L(0); PG8_MMA(0, 0, At, B0); PG8_BAR; PG8_SCHED;
            PG8_LDB(B1, 1, 1); PG8_STAGE(PG8_SB(1, 0), b3, voffB);
            PG8_BAR; PG8_WAIT_L(0); PG8_MMA(0, 1, At, B1); PG8_BAR;
            PG8_LDA(At, 1, 1); PG8_STAGE(PG8_SA(1, 0), a3, voffA);
            PG8_BAR; PG8_WAIT_L(0); PG8_MMA(1, 0, At, B0); PG8_BAR; PG8_SCHED;
            PG8_STAGE(PG8_SB(1, 1), b3 + hstep, voffB);
            PG8_WAIT_V(6); PG8_BAR; PG8_MMA(1, 1, At, B1); PG8_BAR;
            }
        }
        if constexpr (ALIGN_EPI) { if (wr == 0) PG8_BAR; }
        if constexpr (!Epi::AFTER_DRAIN) { E(acc, cur, wr, wc, fr, fq); S.done(cur); }
        if (!has_next) break;
#pragma unroll
        for (int a = 0; a < 2; ++a)
#pragma unroll
            for (int b = 0; b < 2; ++b)
#pragma unroll
                for (int m = 0; m < 4; ++m)
#pragma unroll
                    for (int n = 0; n < 2; ++n) acc[a][b][m][n] = (f32x4){0.f, 0.f, 0.f, 0.f};
        cur = nxt; cA = nA; cB = nB; ++ui;
        if constexpr (ALIGN_EPI) { if (wr == 1) PG8_BAR; }
    }
    PG8_WAIT_V(0);
    if constexpr (!ALIGN_EPI) { if (wr == 0) PG8_BAR; }
    PG8_BAR;
#undef PG8_SA
#undef PG8_SB
#undef PG8_STAGE
#undef PG8_LDA
#undef PG8_LDB
#undef PG8_MMA
#undef PG8_WAIT_V
#undef PG8_WAIT_L
#undef PG8_BAR
#undef PG8_SCHED
}
}

struct Args { const float* in[22]; float* out; unsigned char* ws; };
enum { I_X = 0, I_C, I_MODW, I_MODB, I_NMIX, I_NMLP, I_NFIN, I_RGWIN, I_RGCW, I_RGCB, I_RGWA, I_RGBA, I_RGWX, I_RGBX, I_RGLAM, I_RGWOUT, I_HGWIN, I_HGLB, I_HGGN, I_HGWOUT, I_W1, I_W2 };

__device__ __forceinline__ unsigned f2bf(float f) { unsigned u = __builtin_bit_cast(unsigned, f); return (u + 0x7fffu + ((u >> 16) & 1u)) >> 16; }
__device__ __forceinline__ unsigned pk2(float lo, float hi) { return f2bf(lo) | (f2bf(hi) << 16); }
__device__ __forceinline__ void transpose_item(const float* W, int K, int N, bf16_t* WT, LAS float* scr, int item, int lane) {
    const int nblk = N / 32, kb = item / nblk, nb = item % nblk, k0 = 64 * kb, n0 = 32 * nb;
    f32x4 tv[8];
#pragma unroll
    for (int i = 0; i < 8; ++i) tv[i] = *(const f32x4*)(W + (size_t)(k0 + 8 * i + (lane >> 3)) * N + n0 + 4 * (lane & 7));
#pragma unroll
    for (int i = 0; i < 8; ++i) { LAS float* d = scr + (8 * i + (lane >> 3)) * 33 + 4 * (lane & 7); d[0] = tv[i][0]; d[1] = tv[i][1]; d[2] = tv[i][2]; d[3] = tv[i][3]; }
    asm volatile("s_waitcnt lgkmcnt(0)" ::: "memory");
    const int c = lane & 7;
#pragma unroll
    for (int j = 0; j < 4; ++j) { const int n = (lane >> 3) + 8 * j; const LAS float* s = scr + (8 * c) * 33 + n;
        u32x4 o; o.x = pk2(s[0 * 33], s[1 * 33]); o.y = pk2(s[2 * 33], s[3 * 33]); o.z = pk2(s[4 * 33], s[5 * 33]); o.w = pk2(s[6 * 33], s[7 * 33]);
        st16_wt(WT + (size_t)(n0 + n) * K + k0 + 8 * c, o); }
    asm volatile("s_waitcnt lgkmcnt(0)" ::: "memory");
}

__device__ __forceinline__ void prologue(LAS unsigned char* lds, const Args& a, int vcu, int G, int wv) {
    const int tid = opaque_tid(wv), lane = tid & 63, w = tid >> 6;
    unsigned char* ws = a.ws;
    LAS float* CS = (LAS float*)lds;
    LAS float* RED = (LAS float*)(lds + 106496);
    for (int i = tid; i < NB * D; i += 512) { const int b = i >> 10, k = i & 1023; const float cv = a.in[I_C][i]; CS[k * 8 + b] = cv * fsigmoid(cv); }
    LBAR();
    float* mod = (float*)(ws + WS_MOD);
    for (int it = blockIdx.x; it < DEPTH * (MODW / 32); it += G) {
        const int l = it / (MODW / 32), n0 = (it % (MODW / 32)) * 32;
        const float* Wp = a.in[I_MODW] + (size_t)l * D * MODW + n0 + (lane & 31);
        float acc[8];
#pragma unroll
        for (int b = 0; b < 8; ++b) acc[b] = 0.f;
#pragma unroll 32
        for (int i = 0; i < 64; ++i) { const int k = w * 128 + 2 * i + (lane >> 5); const float wv = Wp[(size_t)k * MODW];
            const f32x4 c0 = *(const LAS f32x4*)(CS + k * 8), c1 = *(const LAS f32x4*)(CS + k * 8 + 4);
            acc[0] += c0[0] * wv; acc[1] += c0[1] * wv; acc[2] += c0[2] * wv; acc[3] += c0[3] * wv; acc[4] += c1[0] * wv; acc[5] += c1[1] * wv; acc[6] += c1[2] * wv; acc[7] += c1[3] * wv; }
#pragma unroll
        for (int b = 0; b < 8; ++b) { acc[b] += __shfl_xor(acc[b], 32); if (lane < 32) RED[(w * 8 + b) * 32 + lane] = acc[b]; }
        LBAR();
        if (tid < 256) { const int b = tid >> 5, col = tid & 31; float s = a.in[I_MODB][l * MODW + n0 + col];
#pragma unroll
            for (int ww = 0; ww < 8; ++ww) s += RED[(ww * 8 + b) * 32 + col];
            mod[((size_t)l * NB + b) * MODW + n0 + col] = s; }
        LBAR();
    }
    if (blockIdx.x == 0) { float* LB = (float*)(ws + WS_LB);
        for (int c = tid; c < D; c += 512) { const float v0 = a.in[I_HGLB][c], v1 = a.in[I_HGLB][D + c], v2 = a.in[I_HGLB][2 * D + c], v3 = a.in[I_HGLB][3 * D + c];
            const float mx = fmaxf(fmaxf(v0, v1), fmaxf(v2, v3)); const float e0 = expf(v0 - mx), e1 = expf(v1 - mx), e2 = expf(v2 - mx), e3 = expf(v3 - mx); const float inv = 1.0f / (e0 + e1 + e2 + e3);
            LB[c] = e1 * inv; LB[D + c] = (e1 + e2 + e3) * inv; } }
    LAS float* scr = (LAS float*)(lds + 32768 + w * 8448);
    const int gw = vcu * 8 + w, NGW = G * 8;
    constexpr int I_RGIN = 1024, I_SQ = 512, I_AX = 8, I_BIGW = 2048;
    constexpr int NIT = 2 * I_RGIN + 2 * I_SQ + 32 * I_AX + 2 * I_BIGW + 2 * I_SQ + 4 * I_BIGW + 4 * I_BIGW;
    for (int it = gw; it < NIT; it += NGW) {
        int r = it;
        if (r < 2 * I_RGIN) { const int j = r / I_RGIN; transpose_item(a.in[I_RGWIN] + (size_t)j * D * 2048, D, 2048, (bf16_t*)(ws + W_RGIN) + (size_t)j * 2048 * D, scr, r % I_RGIN, lane); continue; } r -= 2 * I_RGIN;
        if (r < 2 * I_SQ) { const int j = r / I_SQ; transpose_item(a.in[I_RGWOUT] + (size_t)j * D * D, D, D, (bf16_t*)(ws + W_RGOUT) + (size_t)j * D * D, scr, r % I_SQ, lane); continue; } r -= 2 * I_SQ;
        if (r < 32 * I_AX) { const int mi = r / I_AX; const float* src = (mi < 16 ? a.in[I_RGWA] : a.in[I_RGWX]) + (size_t)(mi & 15) * 16384;
            transpose_item(src, 128, 128, (bf16_t*)(ws + W_RGAX) + (size_t)mi * 16384, scr, r % I_AX, lane); continue; } r -= 32 * I_AX;
        if (r < 2 * I_BIGW) { const int j = r / I_BIGW; transpose_item(a.in[I_HGWIN] + (size_t)j * D * FF, D, FF, (bf16_t*)(ws + W_HGIN) + (size_t)j * FF * D, scr, r % I_BIGW, lane); continue; } r -= 2 * I_BIGW;
        if (r < 2 * I_SQ) { const int j = r / I_SQ; transpose_item(a.in[I_HGWOUT] + (size_t)j * D * D, D, D, (bf16_t*)(ws + W_HGOUT) + (size_t)j * D * D, scr, r % I_SQ, lane); continue; } r -= 2 * I_SQ;
        if (r < 4 * I_BIGW) { const int l = r / I_BIGW; transpose_item(a.in[I_W1] + (size_t)l * D * FF, D, FF, (bf16_t*)(ws + W_W1) + (size_t)l * FF * D, scr, r % I_BIGW, lane); continue; } r -= 4 * I_BIGW;
        { const int l = r / I_BIGW; transpose_item(a.in[I_W2] + (size_t)l * FF * D, FF, D, (bf16_t*)(ws + W_W2) + (size_t)l * D * FF, scr, r % I_BIGW, lane); }
    }
}

template <bool FINAL>
__device__ __forceinline__ void norm_phase(const float* x, const float* gain, const float* sh, const float* sc, bf16_t* o16, float* o32, int vcu, int G, int wv) {
    const int tid = opaque_tid(wv), lane = tid & 63, gw = vcu * 8 + __builtin_amdgcn_readfirstlane(tid >> 6), ngw = G * 8;
    for (int r0 = gw * 8; r0 < M; r0 += ngw * 8) {
        const int b = r0 / T;
        f32x4 g[4], s[4];
#pragma unroll
        for (int j = 0; j < 4; ++j) { const int k = 4 * lane + 256 * j; g[j] = *(const f32x4*)(gain + k);
            if (!FINAL) { const f32x4 scv = *(const f32x4*)(sc + (size_t)b * MODW + k); g[j] = g[j] * (1.0f + scv); s[j] = *(const f32x4*)(sh + (size_t)b * MODW + k); } }
#pragma unroll 2
        for (int r = r0; r < r0 + 8; ++r) {
            const f32x4* xr = (const f32x4*)(x + (size_t)r * D) + lane;
            f32x4 v[4]; float ss = 0.f;
#pragma unroll
            for (int j = 0; j < 4; ++j) { v[j] = xr[64 * j]; ss += (v[j][0] * v[j][0] + v[j][1] * v[j][1]) + (v[j][2] * v[j][2] + v[j][3] * v[j][3]); }
            const float rs = rsqrtf(wave_sum(ss) * (1.0f / D) + NORM_EPS);
            if (FINAL) {
                f32x4* op = (f32x4*)(o32 + (size_t)r * D) + lane;
#pragma unroll
                for (int j = 0; j < 4; ++j) op[64 * j] = v[j] * rs * g[j];
            } else {
                u32x2* op = (u32x2*)(o16 + (size_t)r * D) + lane;
#pragma unroll
                for (int j = 0; j < 4; ++j) { const f32x4 y = v[j] * rs * g[j] + s[j]; u32x2 wv; wv.x = cvt_pk_bf16(y[0], y[1]); wv.y = cvt_pk_bf16(y[2], y[3]); op[64 * j] = wv; }
            }
        }
    }
}

__device__ __forceinline__ void norm0_phase(const float* x, const float* gain, const float* sc, bf16_t* o16, float* ss, int vcu, int G, int wv) {
    const int tid = opaque_tid(wv), lane = tid & 63, gw = vcu * 8 + __builtin_amdgcn_readfirstlane(tid >> 6), ngw = G * 8;
    for (int r0 = gw * 8; r0 < M; r0 += ngw * 8) {
        const int b = r0 / T;
        f32x4 g[2][2];
#pragma unroll
        for (int j = 0; j < 2; ++j)
#pragma unroll
            for (int n = 0; n < 2; ++n) { const int k = 8 * lane + 512 * j + 4 * n; g[j][n] = *(const f32x4*)(gain + k) * (1.0f + *(const f32x4*)(sc + (size_t)b * MODW + k)); }
#pragma unroll 4
        for (int r = r0; r < r0 + 8; ++r) {
            const float* xr = x + (size_t)r * D + 8 * lane;
            f32x4 v[2][2]; float sq = 0.f;
#pragma unroll
            for (int j = 0; j < 2; ++j)
#pragma unroll
                for (int n = 0; n < 2; ++n) { v[j][n] = *(const f32x4*)(xr + 512 * j + 4 * n); sq += (v[j][n][0] * v[j][n][0] + v[j][n][1] * v[j][n][1]) + (v[j][n][2] * v[j][n][2] + v[j][n][3] * v[j][n][3]); }
            sq = wave_sum(sq);
#pragma unroll
            for (int j = 0; j < 2; ++j) { const f32x4 y0 = v[j][0] * g[j][0], y1 = v[j][1] * g[j][1];
                st16_wt(o16 + (size_t)r * D + 8 * lane + 512 * j, (u32x4){cvt_pk_bf16(y0[0], y0[1]), cvt_pk_bf16(y0[2], y0[3]), cvt_pk_bf16(y1[0], y1[1]), cvt_pk_bf16(y1[2], y1[3])}); }
            if (lane < 4) *(f32x4*)(ss + (size_t)r * 16 + 4 * lane) = (f32x4){lane == 0 ? sq : 0.f, 0.f, 0.f, 0.f};
        }
    }
}
__device__ __forceinline__ void shw_phase(const Args& a, int vcu, int G, int wv) {
    const int tid = opaque_tid(wv), lane = tid & 63, gw = vcu * 8 + __builtin_amdgcn_readfirstlane(tid >> 6), ngw = G * 8;
    const float* mod = (const float*)(a.ws + WS_MOD); float* shw = (float*)(a.ws + WS_SHW);
    for (int grp = gw; grp < 28672 / 16; grp += ngw) {
        const int c = grp * 16, seg = c >> 11;
        const int gi = (int)((0x77665543322110ull >> (4 * seg)) & 15ull), n0 = c - 2048 * (int)((0xCA875310u >> (4 * gi)) & 15u);
        const int l = gi >> 1;
        const bf16_t* wbase = (gi & 1) ? (const bf16_t*)(a.ws + W_W1) + ((size_t)l * FF + n0) * D
                            : ((l & 1) ? (const bf16_t*)(a.ws + W_HGIN) + ((size_t)(l >> 1) * FF + n0) * D : (const bf16_t*)(a.ws + W_RGIN) + ((size_t)(l >> 1) * 2048 + n0) * D);
        for (int bg = 0; bg < 2; ++bg) {
            f32x4 sh[4][4];
#pragma unroll
            for (int b = 0; b < 4; ++b)
#pragma unroll
                for (int q = 0; q < 4; ++q) sh[b][q] = *(const f32x4*)(mod + ((size_t)l * NB + bg * 4 + b) * MODW + ((gi & 1) ? 3 * D : 0) + lane * 16 + 4 * q);
#pragma unroll 2
            for (int cc = 0; cc < 16; ++cc) {
                const bf16_t* wrow = wbase + (size_t)cc * D;
                const u32x4 w0 = *(const u32x4*)(wrow + lane * 16), w1 = *(const u32x4*)(wrow + lane * 16 + 8);
                const f32x4 wf0 = {bf_lo(w0.x), bf_hi(w0.x), bf_lo(w0.y), bf_hi(w0.y)}, wf1 = {bf_lo(w0.z), bf_hi(w0.z), bf_lo(w0.w), bf_hi(w0.w)};
                const f32x4 wf2 = {bf_lo(w1.x), bf_hi(w1.x), bf_lo(w1.y), bf_hi(w1.y)}, wf3 = {bf_lo(w1.z), bf_hi(w1.z), bf_lo(w1.w), bf_hi(w1.w)};
                float res = 0.f;
#pragma unroll
                for (int b = 0; b < 4; ++b) { const f32x4 p = (sh[b][0] * wf0 + sh[b][1] * wf1) + (sh[b][2] * wf2 + sh[b][3] * wf3); const float t = wave_sum((p[0] + p[1]) + (p[2] + p[3])); if (lane == b) res = t; }
                if (lane < 4) shw[((size_t)gi * 8 + bg * 4 + lane) * 4096 + n0 + cc] = res;
            }
        }
    }
}

__device__ __forceinline__ void rg_phase(LAS unsigned char* lds, const Args& a, int j, int vcu, int G, int wv) {
    const int tid = opaque_tid(wv), lane = tid & 63, w = tid >> 6, lo = lane & 15, fq = lane >> 4;
    LAS bf16_t* XB0 = (LAS bf16_t*)(lds);
    LAS bf16_t* XC = (LAS bf16_t*)(lds + 67584);
    LAS float* WT = (LAS float*)(lds + 102400);
    LAS float* HS = (LAS float*)(lds + 106496);
    LAS float* CW = (LAS float*)(lds + 124928);
    const char* bigb = (const char*)(a.ws + WS_BIG);
    char* a2b = (char*)(a.ws + WS_A2);
    const bf16_t* WAX = (const bf16_t*)(a.ws + W_RGAX);
    const int cg8 = tid & 15, tg = tid >> 4;
    const int otok = tid >> 2, oc8 = (tid & 3) * 8;
    const unsigned tq = (unsigned)((tid >> 4) * 2048 + (tid & 15) * 8) * 2u;
    for (int it = vcu; it < 256; it += G) {
        const int b = it >> 5, h = (it >> 2) & 7, ns = it & 3;
        bf16x8 wf[2][2][4];
#pragma unroll
        for (int gg = 0; gg < 2; ++gg)
#pragma unroll
            for (int ct = 0; ct < 2; ++ct)
#pragma unroll
                for (int ks = 0; ks < 4; ++ks)
                    wf[gg][ct][ks] = *(const bf16x8*)(WAX + (size_t)((gg * 2 + j) * 8 + h) * 16384 + (ns * 32 + ct * 16 + lo) * 128 + ks * 32 + fq * 8);
        float ba[2], bx[2], sp8[2], carry[2];
#pragma unroll
        for (int ct = 0; ct < 2; ++ct) { const int ch = j * D + h * 128 + ns * 32 + ct * 16 + lo; ba[ct] = a.in[I_RGBA][ch]; bx[ct] = a.in[I_RGBX][ch];
            sp8[ct] = 8.0f * log1pf(expf(-a.in[I_RGLAM][ch])); carry[ct] = 0.f; }
        if (tid < 128) {
#pragma unroll
            for (int tap = 0; tap < 4; ++tap) CW[tap * 128 + tid] = a.in[I_RGCW][(size_t)(j * 4 + tap) * D + h * 128 + tid];
            CW[4 * 128 + tid] = a.in[I_RGCB][j * D + h * 128 + tid]; }
        const unsigned xoff = (unsigned)(b * T) * 4096u + (unsigned)(h * 128) * 2u;
        const unsigned goff = (unsigned)(b * T) * 4096u + (unsigned)(1024 + h * 128 + ns * 32 + oc8) * 2u + (unsigned)otok * 4096u;
        const unsigned ooff = (unsigned)(b * T) * 2048u + (unsigned)(h * 128 + ns * 32 + oc8) * 2u + (unsigned)otok * 2048u;
        {
#pragma unroll
            for (int i = 0; i < 4; ++i) { const u32x4 v = *(const u32x4*)(bigb + (size_t)(xoff + (unsigned)(32 * i) * 4096u + tq));
                *(LAS u32x4*)(XB0 + (3 + 32 * i + tg) * 128 + cg8 * 8) = v; }
            if (tid < 48) { unsigned zz = 0u; asm volatile("" : "+v"(zz)); u32x4 z; z.x = zz; z.y = zz; z.z = zz; z.w = zz; *(LAS u32x4*)(XB0 + (tid >> 4) * 128 + (tid & 15) * 8) = z; }
        }
        LBAR();
        for (int tt = 0; tt < 16; ++tt) {
            const int t0 = tt * 128;
            LAS bf16_t* XB = XB0 + (tt & 1) * 16896;
            LAS bf16_t* XBn = XB0 + ((tt + 1) & 1) * 16896;
            LAS float* WTc = WT + (tt & 1) * 512;
            u32x4 nx[4];
            if (tt + 1 < 16) {
#pragma unroll
                for (int i = 0; i < 4; ++i) nx[i] = *(const u32x4*)(bigb + (size_t)(xoff + (unsigned)(t0 + 128 + 32 * i) * 4096u + tq));
            }
            const u32x4 gt = *(const u32x4*)(bigb + (size_t)(goff + (unsigned)t0 * 4096u));
            {
                u32x4 xr[7];
#pragma unroll
                for (int r = 0; r < 7; ++r) xr[r] = *(const LAS u32x4*)(XB + (4 * tg + r) * 128 + cg8 * 8);
                float o[4][8];
                { const f32x4 b0 = *(const LAS f32x4*)(CW + 512 + cg8 * 8), b1 = *(const LAS f32x4*)(CW + 512 + cg8 * 8 + 4);
#pragma unroll
                    for (int tok = 0; tok < 4; ++tok) { o[tok][0] = b0[0]; o[tok][1] = b0[1]; o[tok][2] = b0[2]; o[tok][3] = b0[3]; o[tok][4] = b1[0]; o[tok][5] = b1[1]; o[tok][6] = b1[2]; o[tok][7] = b1[3]; } }
#pragma unroll
                for (int tap = 0; tap < 4; ++tap) { const f32x4 c0 = *(const LAS f32x4*)(CW + tap * 128 + cg8 * 8), c1 = *(const LAS f32x4*)(CW + tap * 128 + cg8 * 8 + 4);
#pragma unroll
                    for (int tok = 0; tok < 4; ++tok) { const u32x4 xv = xr[tok + tap];
                        o[tok][0] += c0[0] * bf_lo(xv.x); o[tok][1] += c0[1] * bf_hi(xv.x); o[tok][2] += c0[2] * bf_lo(xv.y); o[tok][3] += c0[3] * bf_hi(xv.y);
                        o[tok][4] += c1[0] * bf_lo(xv.z); o[tok][5] += c1[1] * bf_hi(xv.z); o[tok][6] += c1[2] * bf_lo(xv.w); o[tok][7] += c1[3] * bf_hi(xv.w); } }
#pragma unroll
                for (int tok = 0; tok < 4; ++tok) { u32x4 pw; pw.x = cvt_pk_bf16(o[tok][0], o[tok][1]); pw.y = cvt_pk_bf16(o[tok][2], o[tok][3]); pw.z = cvt_pk_bf16(o[tok][4], o[tok][5]); pw.w = cvt_pk_bf16(o[tok][6], o[tok][7]);
                    *(LAS u32x4*)(XC + (4 * tg + tok) * 136 + cg8 * 8) = pw; }
            }
            asm volatile("s_waitcnt lgkmcnt(0)" ::: "memory");
            f32x4 accR[2], accI[2];
#pragma unroll
            for (int ct = 0; ct < 2; ++ct) { accR[ct] = (f32x4){0.f, 0.f, 0.f, 0.f}; accI[ct] = (f32x4){0.f, 0.f, 0.f, 0.f}; }
#pragma unroll
            for (int ks = 0; ks < 4; ++ks) { const bf16x8 af = *(const LAS bf16x8*)(XC + (16 * w + lo) * 136 + ks * 32 + fq * 8);
#pragma unroll
                for (int ct = 0; ct < 2; ++ct) { accR[ct] = __builtin_amdgcn_mfma_f32_16x16x32_bf16(af, wf[0][ct][ks], accR[ct], 0, 0, 0);
                    accI[ct] = __builtin_amdgcn_mfma_f32_16x16x32_bf16(af, wf[1][ct][ks], accI[ct], 0, 0, 0); } }
            float av[2][4], uv[2][4], Pe[2], Qe[2];
#pragma unroll
            for (int ct = 0; ct < 2; ++ct) { float P = 1.f, Q = 0.f;
#pragma unroll
                for (int jj = 0; jj < 4; ++jj) { const int tl = 16 * w + 4 * fq + jj;
                    const float xcv = bf1(XC[tl * 136 + ns * 32 + ct * 16 + lo]);
                    const float r = fsigmoid(accR[ct][jj] + ba[ct]), ig = fsigmoid(accI[ct][jj] + bx[ct]);
                    const float la = -sp8[ct] * r; const float aa = fexp(la);
                    const float xx = -2.0f * la; const float m2 = xx < 0.03f ? xx * (1.0f - xx * (0.5f - xx * (0.16666667f - xx * 0.041666667f))) : 1.0f - aa * aa;
                    float mult = __builtin_amdgcn_sqrtf(m2); if (t0 + tl == 0) mult = 1.0f;
                    const float uu = mult * ig * xcv;
                    av[ct][jj] = aa; uv[ct][jj] = uu; Q = aa * Q + uu; P = P * aa; }
                float Pp = __shfl_up(P, 16), Qp = __shfl_up(Q, 16);
                if (fq >= 1) { Q = P * Qp + Q; P = P * Pp; }
                Pp = __shfl_up(P, 32); Qp = __shfl_up(Q, 32);
                if (fq >= 2) { Q = P * Qp + Q; P = P * Pp; }
                Pp = __shfl_up(P, 16); Qp = __shfl_up(Q, 16);
                Pe[ct] = fq >= 1 ? Pp : 1.f; Qe[ct] = fq >= 1 ? Qp : 0.f;
                if (fq == 3) { WTc[(w * 32 + ct * 16 + lo) * 2] = P; WTc[(w * 32 + ct * 16 + lo) * 2 + 1] = Q; } }
            if (tt + 1 < 16) {
#pragma unroll
                for (int i = 0; i < 4; ++i) *(LAS u32x4*)(XBn + (3 + 32 * i + tg) * 128 + cg8 * 8) = nx[i];
                if (tid < 48) { const u32x4 hv = *(const LAS u32x4*)(XB + (128 + (tid >> 4)) * 128 + (tid & 15) * 8); *(LAS u32x4*)(XBn + (tid >> 4) * 128 + (tid & 15) * 8) = hv; }
            }
            LBAR();
#pragma unroll
            for (int ct = 0; ct < 2; ++ct) { float hc = carry[ct], hin = 0.f;
#pragma unroll
                for (int ww = 0; ww < 8; ++ww) { const f32x2 pq = *(const LAS f32x2*)(WTc + (ww * 32 + ct * 16 + lo) * 2); if (ww == w) hin = hc; hc = pq.x * hc + pq.y; }
                carry[ct] = hc;
                float hh = Pe[ct] * hin + Qe[ct];
#pragma unroll
                for (int jj = 0; jj < 4; ++jj) { hh = av[ct][jj] * hh + uv[ct][jj]; HS[(16 * w + 4 * fq + jj) * 36 + ct * 16 + lo] = hh; } }
            asm volatile("s_waitcnt lgkmcnt(0)" ::: "memory");
            {
                const f32x4 h0 = *(const LAS f32x4*)(HS + otok * 36 + oc8), h1 = *(const LAS f32x4*)(HS + otok * 36 + oc8 + 4);
                u32x4 ow; ow.x = cvt_pk_bf16(h0[0] * bf_lo(gt.x), h0[1] * bf_hi(gt.x)); ow.y = cvt_pk_bf16(h0[2] * bf_lo(gt.y), h0[3] * bf_hi(gt.y));
                ow.z = cvt_pk_bf16(h1[0] * bf_lo(gt.z), h1[1] * bf_hi(gt.z)); ow.w = cvt_pk_bf16(h1[2] * bf_lo(gt.w), h1[3] * bf_hi(gt.w));
                st16_wt(a2b + (size_t)(ooff + (unsigned)t0 * 2048u), ow);
            }
            asm volatile("s_waitcnt lgkmcnt(0)" ::: "memory");
        }
        LBAR();
    }
}

__device__ __forceinline__ void hg_phase(LAS unsigned char* lds, const Args& a, int jj_layer, int vcu, int G, int wv) {
    const int tid = opaque_tid(wv), lane = tid & 63, w = tid >> 6, lo = lane & 15, fq = lane >> 4;
    LAS bf16_t* QT = (LAS bf16_t*)(lds);
    LAS bf16_t* KT = (LAS bf16_t*)(lds + 17408);
    LAS float* OB = (LAS float*)(lds);
    LAS bf16_t* KH = (LAS bf16_t*)(lds + 34816);
    LAS bf16_t* VT = (LAS bf16_t*)(lds + 53248);
    LAS bf16_t* AM = (LAS bf16_t*)(lds + 71680);
    LAS bf16_t* ST = (LAS bf16_t*)(lds + 80896);
    LAS float* ET = (LAS float*)(lds + 115712);
    LAS float* EL = (LAS float*)(lds + 119808);
    const bf16_t* BIG = (const bf16_t*)(a.ws + WS_BIG);
    bf16_t* A2 = (bf16_t*)(a.ws + WS_A2);
    for (int it = vcu; it < 256; it += G) {
        const int b = it >> 5, h = (it >> 2) & 7, q = it & 3;
        const int n_start = (int)((0x1C170E00u >> (8 * q)) & 255u), n_end = (q == 3) ? 32 : (int)((0x1C170E00u >> (8 * q + 8)) & 255u);
        const size_t rowbase = (size_t)b * T;
        f32x4 Sacc[8];
#pragma unroll
        for (int vt = 0; vt < 8; ++vt) Sacc[vt] = (f32x4){0.f, 0.f, 0.f, 0.f};
        for (int i = tid; i < 128 * 136 / 2; i += 512) ((LAS unsigned*)ST)[i] = 0u;
        const int otok = tid >> 3, ovc = tid & 7;
        f32x4 gw[4];
#pragma unroll
        for (int i = 0; i < 4; ++i) gw[i] = *(const f32x4*)(a.in[I_HGGN] + jj_layer * 128 + ovc * 16 + 4 * i);
        LBAR();
        unsigned q2[8], k2[8]; u32x4 va, vb;
        const int vsp = tid & 31, vvc = tid >> 5;
#define HG_LOAD_KV(R0) do { _Pragma("unroll") for (int j = 0; j < 8; ++j) k2[j] = *(const unsigned*)(BIG + ((R0) + 8 * w + j) * FF + 1024 + h * 128 + 2 * lane); \
            va = *(const u32x4*)(BIG + ((R0) + 2 * vsp) * FF + 2048 + h * 128 + vvc * 8); vb = *(const u32x4*)(BIG + ((R0) + 2 * vsp + 1) * FF + 2048 + h * 128 + vvc * 8); } while (0)
#define HG_LOAD_Q(R0) do { _Pragma("unroll") for (int j = 0; j < 8; ++j) q2[j] = *(const unsigned*)(BIG + ((R0) + 8 * w + j) * FF + h * 128 + 2 * lane); } while (0)
        HG_LOAD_KV(rowbase);
        if (n_start == 0) HG_LOAD_Q(rowbase);
        for (int n = 0; n < n_end; ++n) {
            const bool full = n >= n_start;
            const size_t r0 = rowbase + (size_t)n * 64;
            u32x4 g0, g1;
            if (full) { g0 = *(const u32x4*)(BIG + (r0 + otok) * FF + 3072 + h * 128 + ovc * 16); g1 = *(const u32x4*)(BIG + (r0 + otok) * FF + 3072 + h * 128 + ovc * 16 + 8); }
            {
                const unsigned vaw[4] = {va.x, va.y, va.z, va.w}, vbw[4] = {vb.x, vb.y, vb.z, vb.w};
#pragma unroll
                for (int i = 0; i < 4; ++i) { const unsigned lo2 = (vaw[i] & 0xffffu) | (vbw[i] << 16), hi2 = (vaw[i] >> 16) | (vbw[i] & 0xffff0000u);
                    *(LAS unsigned*)(VT + (vvc * 8 + 2 * i) * 72 + 2 * vsp) = lo2; *(LAS unsigned*)(VT + (vvc * 8 + 2 * i + 1) * 72 + 2 * vsp) = hi2; }
            }
            float ec[2][8], kk[2][8];
            { float p0 = 1.f, p1 = 1.f;
#pragma unroll
                for (int j = 0; j < 8; ++j) { kk[0][j] = h_lo(k2[j]); kk[1][j] = h_hi(k2[j]); p0 *= (1.0f - kk[0][j]); p1 *= (1.0f - kk[1][j]); ec[0][j] = p0; ec[1][j] = p1; }
                *(LAS f32x2*)(ET + w * 128 + 2 * lane) = (f32x2){p0, p1}; }
            LBAR();
            float es[2] = {1.f, 1.f}, el[2];
            { float r0p = 1.f, r1p = 1.f;
#pragma unroll
                for (int ww = 0; ww < 8; ++ww) { const f32x2 e = *(const LAS f32x2*)(ET + ww * 128 + 2 * lane); if (ww == w) { es[0] = r0p; es[1] = r1p; } r0p *= e.x; r1p *= e.y; }
                el[0] = r0p; el[1] = r1p; }
            if (w == 0) *(LAS f32x2*)(EL + 2 * lane) = (f32x2){el[0], el[1]};
            {
                unsigned khw[2][4];
#pragma unroll
                for (int j = 0; j < 8; ++j) {
                    const float e0 = fmaxf(es[0] * ec[0][j], 1e-30f), e1 = fmaxf(es[1] * ec[1][j], 1e-30f);
                    const float i0 = __builtin_amdgcn_rcpf(e0), i1 = __builtin_amdgcn_rcpf(e1);
                    const float ka = kk[0][j] * i0, kb = kk[1][j] * i1;
                    if (full) { const float qa = bf_lo(q2[j]) * e0, qb = bf_hi(q2[j]) * e1;
                        *(LAS unsigned*)(QT + (8 * w + j) * 136 + 2 * lane) = cvt_pk_bf16(qa, qb);
                        *(LAS unsigned*)(KT + (8 * w + j) * 136 + 2 * lane) = cvt_pk_bf16(ka, kb); }
                    const float ha = ka * el[0], hb = kb * el[1];
                    if (j & 1) { khw[0][j >> 1] = cvt_pk_bf16(ec[0][j - 1], ha); khw[1][j >> 1] = cvt_pk_bf16(ec[1][j - 1], hb); }
                    else { ec[0][j] = ha; ec[1][j] = hb; }
                }
                *(LAS u32x4*)(KH + (2 * lane) * 72 + 8 * w) = (u32x4){khw[0][0], khw[0][1], khw[0][2], khw[0][3]};
                *(LAS u32x4*)(KH + (2 * lane + 1) * 72 + 8 * w) = (u32x4){khw[1][0], khw[1][1], khw[1][2], khw[1][3]};
            }
            LBAR();
            if (n + 1 < n_end) { HG_LOAD_KV(r0 + 64); if (n + 1 >= n_start) HG_LOAD_Q(r0 + 64); }
            f32x4 oacc[4];
            if (full) {
                const int tb = w >> 1;
#pragma unroll
                for (int x = 0; x < 2; ++x) { const int ss = 2 * (w & 1) + x; f32x4 c = (f32x4){0.f, 0.f, 0.f, 0.f};
                    if (ss <= tb) {
#pragma unroll
                        for (int ks = 0; ks < 4; ++ks) { const bf16x8 kf = *(const LAS bf16x8*)(KT + (16 * ss + lo) * 136 + ks * 32 + fq * 8), qf = *(const LAS bf16x8*)(QT + (16 * tb + lo) * 136 + ks * 32 + fq * 8);
                            c = __builtin_amdgcn_mfma_f32_16x16x32_bf16(kf, qf, c, 0, 0, 0); } }
                    const int tq = 16 * tb + lo, s0 = 16 * ss + 4 * fq;
                    float m[4];
#pragma unroll
                    for (int e = 0; e < 4; ++e) m[e] = (s0 + e <= tq) ? c[e] : 0.f;
                    *(LAS u32x2*)(AM + tq * 72 + s0) = (u32x2){cvt_pk_bf16(m[0], m[1]), cvt_pk_bf16(m[2], m[3])}; }
                LBAR();
                const int tb2 = w & 3, vh = w >> 2;
                bf16x8 af[2], qf[4];
#pragma unroll
                for (int ks = 0; ks < 2; ++ks) af[ks] = *(const LAS bf16x8*)(AM + (16 * tb2 + lo) * 72 + ks * 32 + fq * 8);
#pragma unroll
                for (int ks = 0; ks < 4; ++ks) qf[ks] = *(const LAS bf16x8*)(QT + (16 * tb2 + lo) * 136 + ks * 32 + fq * 8);
#pragma unroll
                for (int x = 0; x < 4; ++x) { const int vt = 4 * vh + x; f32x4 c = (f32x4){0.f, 0.f, 0.f, 0.f};
#pragma unroll
                    for (int ks = 0; ks < 2; ++ks) { if (ks == 0 || tb2 >= 2) { const bf16x8 vf = *(const LAS bf16x8*)(VT + (16 * vt + lo) * 72 + ks * 32 + fq * 8); c = __builtin_amdgcn_mfma_f32_16x16x32_bf16(af[ks], vf, c, 0, 0, 0); } }
#pragma unroll
                    for (int ks = 0; ks < 4; ++ks) { const bf16x8 sf = *(const LAS bf16x8*)(ST + (16 * vt + lo) * 136 + ks * 32 + fq * 8); c = __builtin_amdgcn_mfma_f32_16x16x32_bf16(qf[ks], sf, c, 0, 0, 0); }
                    oacc[x] = c; }
            }
            {
                const f32x4 dec = *(const LAS f32x4*)(EL + 16 * w + 4 * fq);
                bf16x8 kf[2];
#pragma unroll
                for (int ks = 0; ks < 2; ++ks) kf[ks] = *(const LAS bf16x8*)(KH + (16 * w + lo) * 72 + ks * 32 + fq * 8);
#pragma unroll
                for (int vt = 0; vt < 8; ++vt) { f32x4 c = Sacc[vt] * dec;
#pragma unroll
                    for (int ks = 0; ks < 2; ++ks) { const bf16x8 vf = *(const LAS bf16x8*)(VT + (16 * vt + lo) * 72 + ks * 32 + fq * 8); c = __builtin_amdgcn_mfma_f32_16x16x32_bf16(kf[ks], vf, c, 0, 0, 0); }
                    Sacc[vt] = c; }
            }
            LBAR();
            if (n + 1 >= n_start) {
#pragma unroll
                for (int vt = 0; vt < 8; ++vt) *(LAS u32x2*)(ST + (16 * vt + lo) * 136 + 16 * w + 4 * fq) = (u32x2){cvt_pk_bf16(Sacc[vt][0], Sacc[vt][1]), cvt_pk_bf16(Sacc[vt][2], Sacc[vt][3])};
            }
            if (full) {
                const int tb2 = w & 3, vh = w >> 2;
#pragma unroll
                for (int x = 0; x < 4; ++x)
#pragma unroll
                    for (int e = 0; e < 4; ++e) OB[(16 * tb2 + 4 * fq + e) * 132 + 16 * (4 * vh + x) + lo] = oacc[x][e];
                LBAR();
                f32x4 ov[4]; float ss = 0.f;
#pragma unroll
                for (int i = 0; i < 4; ++i) { ov[i] = *(const LAS f32x4*)(OB + otok * 132 + ovc * 16 + 4 * i); ss += (ov[i][0] * ov[i][0] + ov[i][1] * ov[i][1]) + (ov[i][2] * ov[i][2] + ov[i][3] * ov[i][3]); }
                ss += __shfl_xor(ss, 1); ss += __shfl_xor(ss, 2); ss += __shfl_xor(ss, 4);
                const float rs = rsqrtf(ss * (1.0f / 128.0f) + GNORM_EPS);
                const unsigned gwd[8] = {g0.x, g0.y, g0.z, g0.w, g1.x, g1.y, g1.z, g1.w};
                unsigned ow[8];
#pragma unroll
                for (int i = 0; i < 4; ++i) { const f32x4 y = ov[i] * rs * gw[i];
                    ow[2 * i] = cvt_pk_bf16(y[0] * bf_lo(gwd[2 * i]), y[1] * bf_hi(gwd[2 * i])); ow[2 * i + 1] = cvt_pk_bf16(y[2] * bf_lo(gwd[2 * i + 1]), y[3] * bf_hi(gwd[2 * i + 1])); }
                bf16_t* op = A2 + (r0 + otok) * D + h * 128 + ovc * 16;
                st16_wt(op, (u32x4){ow[0], ow[1], ow[2], ow[3]}); st16_wt(op + 8, (u32x4){ow[4], ow[5], ow[6], ow[7]});
                LBAR();
            }
        }
        LBAR();
    }
#undef HG_LOAD_KV
#undef HG_LOAD_Q
}

#define XB_TMO      128
#define XB_XCNT(j)  (256  + 64 * (j))
#define XB_XSUB(j)  (1280 + 64 * (j))
#define XB_XGEN(j)  (2304 + 64 * (j))
#define XB_TOP      3328
#define XB_TOPGEN   3392
#define XCD_BAR_WORDS 3456
#define XB_SPIN_CAP (1u << 18)

__device__ __forceinline__ unsigned xb_ld(unsigned* p)              { return __hip_atomic_load(p, __ATOMIC_RELAXED, __HIP_MEMORY_SCOPE_AGENT); }
__device__ __forceinline__ unsigned xb_add(unsigned* p, unsigned v) { return __hip_atomic_fetch_add(p, v, __ATOMIC_RELAXED, __HIP_MEMORY_SCOPE_AGENT); }
__device__ __forceinline__ unsigned xb_xcc_id() { return (unsigned)__builtin_amdgcn_s_getreg((3 << 11) | 20) & 0xFu; }
#define XB_SPIN(cond, bar) do { unsigned _sp = 0; while (cond) { __builtin_amdgcn_s_sleep(1); \
    if ((++_sp & 255u) == 0u) { if (xb_ld(&(bar)[XB_TMO])) break; if (_sp > XB_SPIN_CAP) { atomicAdd(&(bar)[XB_TMO], 1u); break; } } } } while (0)

struct XcdBarrier {
    unsigned* bar; unsigned x;
    volatile LAS unsigned* st;
};

__device__ __forceinline__ XcdBarrier xcd_barrier_post(unsigned* bar, volatile LAS unsigned* st) {
    XcdBarrier b; b.bar = bar; b.x = xb_xcc_id(); b.st = st;
    if (threadIdx.x == 0) (void)xb_add(&bar[XB_XCNT(b.x)], 1u);
    return b;
}
__device__ __forceinline__ void xcd_barrier_complete(unsigned* bar, unsigned x, unsigned& nloc, unsigned& nx) {
    const unsigned G = gridDim.x * gridDim.y * gridDim.z;
    unsigned sum, cnt, mine, sp = 0u;
    for (;;) {
        sum = 0u; cnt = 0u; mine = 0u;
#pragma unroll
        for (unsigned j = 0; j < 16; ++j) { const unsigned c = xb_ld(&bar[XB_XCNT(j)]); sum += c; cnt += (c > 0u) ? 1u : 0u; mine = (j == x) ? c : mine; }
        if (sum == G) break;
        __builtin_amdgcn_s_sleep(1);
        if ((++sp & 255u) == 0u) { if (xb_ld(&bar[XB_TMO])) break; if (sp > XB_SPIN_CAP) { atomicAdd(&bar[XB_TMO], 1u); break; } }
    }
    nloc = mine > 0u ? mine : 1u; nx = cnt > 0u ? cnt : 1u;
}

__device__ __forceinline__ void xcd_barrier(const XcdBarrier& b) {
    asm volatile("s_waitcnt vmcnt(0)" ::: "memory");
    __syncthreads();
    if (threadIdx.x == 0) {
        unsigned* bar = b.bar;
        __builtin_amdgcn_s_waitcnt(0);
        unsigned nloc = b.st[0], nx = b.st[1];
        if (nloc == 0u) { xcd_barrier_complete(bar, b.x, nloc, nx); b.st[0] = nloc; b.st[1] = nx; }
        const unsigned old = xb_add(&bar[XB_XSUB(b.x)], 1u);
        const unsigned gen = old / nloc;
        if (old + 1u == (gen + 1u) * nloc) {
            __builtin_amdgcn_fence(__ATOMIC_RELEASE, "agent");
            asm volatile("s_waitcnt vmcnt(0)" ::: "memory");
            const unsigned og = xb_add(&bar[XB_TOP], 1u);
            const unsigned tg = og / nx;
            if (og + 1u == (tg + 1u) * nx) xb_add(&bar[XB_TOPGEN], 1u);
            else XB_SPIN(xb_ld(&bar[XB_TOPGEN]) == tg, bar);
            __builtin_amdgcn_fence(__ATOMIC_ACQUIRE, "agent");
            xb_add(&bar[XB_XGEN(b.x)], 1u);
            asm volatile("s_waitcnt vmcnt(0)" ::: "memory");
        } else {
            XB_SPIN(xb_ld(&bar[XB_XGEN(b.x)]) == gen, bar);
            __builtin_amdgcn_fence(__ATOMIC_ACQUIRE, "agent");
            asm volatile("s_waitcnt vmcnt(0)" ::: "memory");
        }
    }
    __syncthreads();
}


#define GRID_SYNC() do { unsigned* _bp = (unsigned*)a.ws; asm volatile("" : "+s"(_bp)); XcdBarrier _xb; _xb.bar = _bp; _xb.x = xb_xcc_id(); _xb.st = (volatile LAS unsigned*)(lds + 131072); xcd_barrier(_xb); } while (0)
__global__ void __launch_bounds__(512, 2) fwd_megakernel(Args a) {
    extern __shared__ __attribute__((aligned(16))) unsigned char lds_raw[];
    LAS unsigned char* lds = (LAS unsigned char*)lds_raw;
    cg::grid_group grid = cg::this_grid();
    const int G = gridDim.x, bx = blockIdx.x;
    const int wv = __builtin_amdgcn_readfirstlane((int)threadIdx.x >> 6);
    const int vcu = (G % 8 == 0) ? (bx % 8) * (G / 8) + bx / 8 : bx;
    unsigned char* ws = a.ws;
    const float* mod = (const float*)(ws + WS_MOD);
    bf16_t* A1 = (bf16_t*)(ws + WS_A1); bf16_t* A2 = (bf16_t*)(ws + WS_A2); bf16_t* BIG = (bf16_t*)(ws + WS_BIG);

    if (threadIdx.x < 2) ((volatile LAS unsigned*)(lds + 131072))[threadIdx.x] = 0u;
    __syncthreads();
    (void)xcd_barrier_post((unsigned*)ws, (volatile LAS unsigned*)(lds + 131072));
    prologue(lds, a, vcu, G, wv);
    if (G > 65535) grid.sync();
    GRID_SYNC();

    const float* xin = a.in[I_X];
    float* SS = (float*)(ws + WS_SS); const float* SHW = (const float*)(ws + WS_SHW);
    norm0_phase(xin, a.in[I_NMIX], mod + 1 * D, A1, SS, vcu, G, wv);
    shw_phase(a, vcu, G, wv);
    GRID_SYNC();
    for (int l = 0; l < DEPTH; ++l) {
        const float* modl = mod + (size_t)l * NB * MODW;
        const int jx = l >> 1;
        if ((l & 1) == 0) {
            { pg8::Gemm g{A1, (const bf16_t*)(ws + W_RGIN) + (size_t)jx * 2048 * D, M, 2048, D}; pg8::StaticOrder S; S.init(M, 2048, G, bx);
              pg8::stage_unit_tables(lds + 131072 + 1024, S, SS, SHW + (size_t)(2 * l) * 8 * 4096, wv);
              pg8::EpiAct<0> E{BIG, 2048, nullptr, lds + 131072 + 1024};
              pg8::gemm_phase<pg8::EpiAct<0>, pg8::StaticOrder, true, true>(lds, g, S, E, wv); }
            GRID_SYNC();
            rg_phase(lds, a, jx, vcu, G, wv);
        } else {
            { pg8::Gemm g{A1, (const bf16_t*)(ws + W_HGIN) + (size_t)jx * FF * D, M, FF, D}; pg8::StaticOrder S; S.init(M, FF, G, bx);
              pg8::stage_unit_tables(lds + 131072 + 1024, S, SS, SHW + (size_t)(2 * l) * 8 * 4096, wv);
              pg8::EpiAct<1> E{BIG, FF, (const float*)(ws + WS_LB) + jx * D, lds + 131072 + 1024};
              pg8::gemm_phase<pg8::EpiAct<1>, pg8::StaticOrder, true, true>(lds, g, S, E, wv); }
            GRID_SYNC();
            hg_phase(lds, a, jx, vcu, G, wv);
        }
        GRID_SYNC();
        { pg8::Gemm g{A2, (l & 1) ? (const bf16_t*)(ws + W_HGOUT) + (size_t)jx * D * D : (const bf16_t*)(ws + W_RGOUT) + (size_t)jx * D * D, M, D, D}; pg8::StaticOrder S; S.init(M, D, G, bx);
          pg8::EpiRes E{xin, a.out, modl + 2 * D, A1, a.in[I_NMLP] + l * D, modl + 4 * D, SS};
          pg8::gemm_phase<pg8::EpiRes, pg8::StaticOrder, true, true>(lds, g, S, E, wv); }
        xin = a.out;
        GRID_SYNC();
        { pg8::Gemm g{A1, (const bf16_t*)(ws + W_W1) + (size_t)l * FF * D, M, FF, D}; pg8::StaticOrder S; S.init(M, FF, G, bx);
          pg8::stage_unit_tables(lds + 131072 + 1024, S, SS, SHW + (size_t)(2 * l + 1) * 8 * 4096, wv);
          pg8::EpiAct<2> E{BIG, FF, nullptr, lds + 131072 + 1024};
          pg8::gemm_phase<pg8::EpiAct<2>, pg8::StaticOrder, true, true>(lds, g, S, E, wv); }
        GRID_SYNC();
        { pg8::Gemm g{BIG, (const bf16_t*)(ws + W_W2) + (size_t)l * D * FF, M, D, FF}; pg8::StaticOrder S; S.init(M, D, G, bx);
          const bool lastl = (l == DEPTH - 1);
          pg8::EpiRes E{xin, a.out, modl + 5 * D, lastl ? nullptr : A1, a.in[I_NMIX] + (lastl ? 0 : (l + 1) * D), mod + (size_t)(lastl ? 0 : (l + 1)) * NB * MODW + 1 * D, SS};
          pg8::gemm_phase<pg8::EpiRes, pg8::StaticOrder, true, true>(lds, g, S, E, wv); }
        GRID_SYNC();
    }
    norm_phase<true>(a.out, a.in[I_NFIN], nullptr, nullptr, nullptr, a.out, vcu, G, wv);
}

extern "C" void kernel_launch(void* const* d_in, const int* in_sizes, int n_in, void* d_out, int out_size, void* d_ws, size_t ws_size, hipStream_t stream) {
    static int grid = 0;
    if (grid == 0) {
        if (n_in != 22 || out_size != M * D || ws_size < WS_END) { fprintf(stderr, "kernel_launch: unexpected shapes (n_in %d out %d ws %zu)\n", n_in, out_size, ws_size); grid = -1; return; }
        int dev = 0, cus = 0, per_cu = 0;
        hipGetDevice(&dev);
        hipDeviceGetAttribute(&cus, hipDeviceAttributeMultiprocessorCount, dev);
        hipFuncSetAttribute((const void*)fwd_megakernel, hipFuncAttributeMaxDynamicSharedMemorySize, LDS_BYTES);
        hipOccupancyMaxActiveBlocksPerMultiprocessor(&per_cu, (const void*)fwd_megakernel, 512, LDS_BYTES);
        if (per_cu < 1) { fprintf(stderr, "kernel_launch: occupancy query says %d blocks/CU\n", per_cu); per_cu = 1; }
        (void)hipGetLastError();
        grid = cus;
    }
    if (grid < 0) return;
    (void)hipMemsetAsync(d_ws, 0, 16384, stream);
    Args a{};
    for (int i = 0; i < 22; ++i) a.in[i] = (const float*)d_in[i];
    a.out = (float*)d_out; a.ws = (unsigned char*)d_ws;
    void* args[] = {&a};
    hipError_t e = hipLaunchCooperativeKernel((const void*)fwd_megakernel, dim3(grid), dim3(512), args, LDS_BYTES, stream);
    if (e != hipSuccess) fprintf(stderr, "cooperative launch failed: %s (grid %d)\n", hipGetErrorString(e), grid);
}
```

```cpp
#include <hip/hip_runtime.h>
#include <hip/hip_cooperative_groups.h>
#include <cstdio>
#include <cstdint>
namespace cg = cooperative_groups;

#define LAS __attribute__((address_space(3)))
typedef unsigned short bf16_t;
typedef short bf16x8 __attribute__((ext_vector_type(8)));
typedef float f32x4 __attribute__((ext_vector_type(4)));
typedef float f32x2 __attribute__((ext_vector_type(2)));
typedef unsigned u32x4 __attribute__((ext_vector_type(4)));
typedef unsigned u32x2 __attribute__((ext_vector_type(2)));

constexpr int NB = 8, T = 2048, D = 1024, M = NB * T, FF = 4096, DEPTH = 4;
constexpr int MODW = 6 * D;
constexpr float NORM_EPS = 1e-6f, GNORM_EPS = 1e-5f;

constexpr size_t MiB = 1u << 20;
constexpr size_t WS_MOD = 1 * MiB;
constexpr size_t WS_LB = WS_MOD + 768 * 1024;
constexpr size_t WS_W = 2 * MiB;
constexpr size_t W_RGIN = WS_W + 0 * MiB, W_RGOUT = WS_W + 8 * MiB, W_RGAX = WS_W + 12 * MiB, W_HGIN = WS_W + 13 * MiB, W_HGOUT = WS_W + 29 * MiB,
                 W_W1 = WS_W + 33 * MiB, W_W2 = WS_W + 65 * MiB;
constexpr size_t WS_A1 = 100 * MiB;
constexpr size_t WS_A2 = 132 * MiB;
constexpr size_t WS_BIG = 164 * MiB;
constexpr size_t WS_SS = 292 * MiB;
constexpr size_t WS_SHW = 293 * MiB;
constexpr size_t WS_END = 294 * MiB;

constexpr int LDS_BYTES = 147456;

#define LBAR() do { asm volatile("s_waitcnt lgkmcnt(0)" ::: "memory"); __builtin_amdgcn_s_barrier(); asm volatile("" ::: "memory"); } while (0)
typedef __bf16 bf16x2_t __attribute__((ext_vector_type(2)));
__device__ __forceinline__ unsigned cvt_pk_bf16(float lo, float hi) { f32x2 v = {lo, hi}; bf16x2_t b = __builtin_convertvector(v, bf16x2_t); return __builtin_bit_cast(unsigned, b); }
__device__ __forceinline__ void st16_wt(void* p, u32x4 v) { *(u32x4*)p = v; }
__device__ __forceinline__ void st16_wt(void* p, f32x4 v) { *(f32x4*)p = v; }
__device__ __forceinline__ float bf_lo(unsigned w) { return __builtin_bit_cast(float, w << 16); }
__device__ __forceinline__ float bf_hi(unsigned w) { return __builtin_bit_cast(float, w & 0xffff0000u); }
__device__ __forceinline__ float bf1(bf16_t v) { return __builtin_bit_cast(float, (unsigned)v << 16); }
__device__ __forceinline__ unsigned pk_f16(float lo, float hi) { typedef _Float16 h2 __attribute__((ext_vector_type(2))); h2 v; v.x = (_Float16)lo; v.y = (_Float16)hi; return __builtin_bit_cast(unsigned, v); }
__device__ __forceinline__ float h_lo(unsigned w) { typedef _Float16 h2 __attribute__((ext_vector_type(2))); h2 v = __builtin_bit_cast(h2, w); return (float)v.x; }
__device__ __forceinline__ float h_hi(unsigned w) { typedef _Float16 h2 __attribute__((ext_vector_type(2))); h2 v = __builtin_bit_cast(h2, w); return (float)v.y; }
__device__ __forceinline__ float fexp(float x) { return __builtin_amdgcn_exp2f(x * 1.4426950408889634f); }
__device__ __forceinline__ float fsigmoid(float x) { return __builtin_amdgcn_rcpf(1.0f + __builtin_amdgcn_exp2f(x * -1.4426950408889634f)); }
__device__ __forceinline__ int opaque_tid(int wv) { int t; asm volatile("v_mbcnt_lo_u32_b32 %0, -1, 0\n\tv_mbcnt_hi_u32_b32 %0, -1, %0" : "=v"(t)); return (wv << 6) + t; }
__device__ __forceinline__ float wave_sum(float v) {
#pragma unroll
    for (int o = 1; o < 64; o <<= 1) v += __shfl_xor(v, o);
    return v;
}

namespace pg8 {
#define PG8_LAS __attribute__((address_space(3)))
constexpr int BM = 256, BK = 64, HALF = 128, HTB = HALF * BK * 2, STAGE_BYTES = 8 * HTB, NXCD = 8, WGM = 8;
__host__ __device__ __forceinline__ int lds_byte(int r, int c) { const int st = (r >> 4) * 2 + (c >> 5), rr = r & 15, cc = c & 31, ob = rr * 64 + cc * 2; return st * 1024 + (ob ^ (((ob >> 9) & 1) << 5)); }
__host__ __device__ __forceinline__ void stage_rc(int b, int& R, int& C) { const int st = b / 1024, sb = b % 1024, swz = sb ^ (((sb >> 9) & 1) << 5); R = (st >> 1) * 16 + swz / 64; C = (st & 1) * 32 + (swz % 64) / 2; }
__host__ __device__ __forceinline__ int perm32(int rho) { const int n = rho >> 4, i = rho & 15; return 8 * (i >> 2) + 4 * n + (i & 3); }

struct Unit { int pm, pn, idx; };
struct Gemm { const bf16_t* A; const bf16_t* Bt; int M, N, K; };
struct StaticOrder {
    int nM, nN, nwg, G, c;
    __host__ __device__ void init(int M_, int N_, int G_, int c_) { nM = M_ / BM; nN = N_ / BM; nwg = nM * nN; G = G_; c = c_; }
    __host__ __device__ bool next(int i, Unit& u) const {
        const long L = (long)i * G + c; if (L >= nwg) return false;
        int wgid = (int)L; { const int q = nwg / NXCD, r = nwg % NXCD, xcd = wgid % NXCD, off = wgid / NXCD; wgid = (xcd < r ? xcd * (q + 1) : r * (q + 1) + (xcd - r) * q) + off; }
        const int nig = WGM * nN, gid = wgid / nig, fm = gid * WGM, gsz = (nM - fm) < WGM ? (nM - fm) : WGM;
        u.pm = fm + ((wgid % nig) % gsz); u.pn = (wgid % nig) / gsz; u.idx = i; return true;
    }
    __device__ __forceinline__ void a_ready(const Unit&) const {}
    __device__ __forceinline__ void done(const Unit&) const {}
};

template <int MODE> struct EpiAct {
    static constexpr bool PERM = true, AFTER_DRAIN = false;
    bf16_t* O; int ldc; const float* lb; PG8_LAS unsigned char* tab;
    __device__ __forceinline__ void operator()(const f32x4 (&acc)[2][2][4][2], const Unit& u, int wr, int wc, int fr, int fq) const {
        const int row0 = u.pm * BM + wr * 64 + fr; const int colt = u.pn * BM; const int blk = colt >> 10;
        const int col0 = colt + wc * 32 + 8 * fq;
        float rsv[8];
        { PG8_LAS const float* rt = (PG8_LAS const float*)(tab + u.idx * 2048) + wr * 64 + fr;
#pragma unroll
            for (int i = 0; i < 8; ++i) rsv[i] = rt[(i >> 2) * HALF + (i & 3) * 16]; }
        f32x4 sw[2][2];
        { PG8_LAS const float* st = (PG8_LAS const float*)(tab + u.idx * 2048 + 1024) + wc * 32 + 8 * fq;
#pragma unroll
            for (int bj = 0; bj < 2; ++bj)
#pragma unroll
                for (int n = 0; n < 2; ++n) sw[bj][n] = *(PG8_LAS const f32x4*)(st + bj * HALF + 4 * n); }
        f32x4 om[2][2];
        if (MODE == 1) {
#pragma unroll
            for (int bj = 0; bj < 2; ++bj)
#pragma unroll
                for (int n = 0; n < 2; ++n) { om[bj][n] = (f32x4){0.f, 0.f, 0.f, 0.f};
                    if (blk == 1) { const f32x4 l = *(const f32x4*)(lb + (col0 - 1024) + bj * HALF + 4 * n); om[bj][n] = 1.0f - l; } }
        }
#pragma unroll
        for (int ai = 0; ai < 2; ++ai)
#pragma unroll
            for (int m = 0; m < 4; ++m) { bf16_t* rowp = O + (size_t)(row0 + ai * HALF + m * 16) * ldc + col0;
#pragma unroll
                for (int bj = 0; bj < 2; ++bj) { f32x4 v[2] = {acc[ai][bj][m][0] * rsv[ai * 4 + m] + sw[bj][0], acc[ai][bj][m][1] * rsv[ai * 4 + m] + sw[bj][1]}; u32x4 w;
                    if (MODE == 0) {
                        if (blk == 1) {
#pragma unroll
                            for (int n = 0; n < 2; ++n)
#pragma unroll
                                for (int e = 0; e < 4; ++e) { const float x = v[n][e]; const float z = 1.5957691216f * (x + 0.044715f * x * x * x); v[n][e] = x * fsigmoid(z); }
                        }
                        w.x = cvt_pk_bf16(v[0][0], v[0][1]); w.y = cvt_pk_bf16(v[0][2], v[0][3]); w.z = cvt_pk_bf16(v[1][0], v[1][1]); w.w = cvt_pk_bf16(v[1][2], v[1][3]);
                    } else if (MODE == 1) {
                        if (blk == 1) {
#pragma unroll
                            for (int n = 0; n < 2; ++n)
#pragma unroll
                                for (int e = 0; e < 4; ++e) v[n][e] = om[bj][n][e] * fsigmoid(-v[n][e]);
                            w.x = pk_f16(v[0][0], v[0][1]); w.y = pk_f16(v[0][2], v[0][3]); w.z = pk_f16(v[1][0], v[1][1]); w.w = pk_f16(v[1][2], v[1][3]);
                        } else {
                            if (blk != 2) {
#pragma unroll
                                for (int n = 0; n < 2; ++n)
#pragma unroll
                                    for (int e = 0; e < 4; ++e) v[n][e] = v[n][e] * fsigmoid(v[n][e]);
                            }
                            w.x = cvt_pk_bf16(v[0][0], v[0][1]); w.y = cvt_pk_bf16(v[0][2], v[0][3]); w.z = cvt_pk_bf16(v[1][0], v[1][1]); w.w = cvt_pk_bf16(v[1][2], v[1][3]);
                        }
                    } else {
#pragma unroll
                        for (int n = 0; n < 2; ++n)
#pragma unroll
                            for (int e = 0; e < 4; ++e) { const float x = fmaxf(v[n][e], 0.f); v[n][e] = x * x; }
                        w.x = cvt_pk_bf16(v[0][0], v[0][1]); w.y = cvt_pk_bf16(v[0][2], v[0][3]); w.z = cvt_pk_bf16(v[1][0], v[1][1]); w.w = cvt_pk_bf16(v[1][2], v[1][3]);
                    }
                    st16_wt(rowp + bj * HALF, w); } }
    }
};
struct EpiRes {
    static constexpr bool PERM = true, AFTER_DRAIN = false;
    const float* xin; float* xout; const float* gate;
    bf16_t* a1; const float* gain; const float* sc; float* ss;
    __device__ __forceinline__ void operator()(const f32x4 (&acc)[2][2][4][2], const Unit& u, int wr, int wc, int fr, int fq) const {
        const int b = (u.pm * BM) / T; const int col0 = u.pn * BM + wc * 32 + 8 * fq;
        f32x4 gv[2][2], gn[2][2];
#pragma unroll
        for (int bj = 0; bj < 2; ++bj)
#pragma unroll
            for (int n = 0; n < 2; ++n) { gv[bj][n] = *(const f32x4*)(gate + (size_t)b * MODW + col0 + bj * HALF + n * 4);
                if (a1) { const f32x4 g0 = *(const f32x4*)(gain + col0 + bj * HALF + n * 4), s0 = *(const f32x4*)(sc + (size_t)b * MODW + col0 + bj * HALF + n * 4); gn[bj][n] = g0 * (1.0f + s0); } }
#pragma unroll
        for (int ai = 0; ai < 2; ++ai)
#pragma unroll
            for (int m = 0; m < 4; ++m) { const int row = u.pm * BM + ai * HALF + wr * 64 + m * 16 + fr; const size_t off = (size_t)row * D + col0; float sq = 0.f;
#pragma unroll
                for (int bj = 0; bj < 2; ++bj) { f32x4 xn[2];
#pragma unroll
                    for (int n = 0; n < 2; ++n) { const f32x4 xi = *(const f32x4*)(xin + off + bj * HALF + n * 4); xn[n] = xi + gv[bj][n] * acc[ai][bj][m][n]; }
                    st16_wt(xout + off + bj * HALF, xn[0]); st16_wt(xout + off + bj * HALF + 4, xn[1]);
                    if (a1) { sq += ((xn[0][0] * xn[0][0] + xn[0][1] * xn[0][1]) + (xn[0][2] * xn[0][2] + xn[0][3] * xn[0][3])) + ((xn[1][0] * xn[1][0] + xn[1][1] * xn[1][1]) + (xn[1][2] * xn[1][2] + xn[1][3] * xn[1][3]));
                        const f32x4 y0 = xn[0] * gn[bj][0], y1 = xn[1] * gn[bj][1];
                        st16_wt(a1 + off + bj * HALF, (u32x4){cvt_pk_bf16(y0[0], y0[1]), cvt_pk_bf16(y0[2], y0[3]), cvt_pk_bf16(y1[0], y1[1]), cvt_pk_bf16(y1[2], y1[3])}); } }
                if (a1) { sq += __shfl_xor(sq, 16); sq += __shfl_xor(sq, 32); if (fq == 0) ss[(size_t)row * 16 + u.pn * 4 + wc] = sq; }
                if (m & 1) asm volatile("" ::: "memory"); }
    }
};

template <class Sched>
__device__ __forceinline__ void stage_unit_tables(PG8_LAS unsigned char* tab, const Sched& S, const float* ss, const float* shw, int wv) {
    const int tid = opaque_tid(wv);
    Unit u;
    for (int i = 0; S.next(i, u); ++i) {
        PG8_LAS float* t = (PG8_LAS float*)(tab + i * 2048);
        if (tid < 256) { const f32x4* sp = (const f32x4*)(ss + (size_t)(u.pm * BM + tid) * 16); const f32x4 sm = (sp[0] + sp[1]) + (sp[2] + sp[3]);
            t[tid] = rsqrtf(((sm[0] + sm[1]) + (sm[2] + sm[3])) * (1.0f / D) + NORM_EPS); }
        else t[tid] = shw[(size_t)((u.pm * BM) / T) * 4096 + u.pn * BM + (tid - 256)];
    }
    asm volatile("s_waitcnt vmcnt(0) lgkmcnt(0)" ::: "memory"); __builtin_amdgcn_s_barrier(); asm volatile("" ::: "memory");
}

template <class Epi, class Sched, bool ALIGN_EPI = false, bool SP2 = false>
__device__ __forceinline__ void gemm_phase(PG8_LAS unsigned char* lds, const Gemm g, const Sched& S, const Epi& E, int wv) {
    const int tid = opaque_tid(wv), wid = __builtin_amdgcn_readfirstlane(tid >> 6), lane = tid & 63, wr = wid >> 2, wc = wid & 3, fr = lane & 15, fq = lane >> 4;
    const int K = g.K, nt = K / BK;
    unsigned voffA[2], voffB[2];
#pragma unroll
    for (int i = 0; i < 2; ++i) { int R, C; stage_rc(tid * 16 + i * 8192, R, C); const int Rb = Epi::PERM ? ((R & ~31) + perm32(R & 31)) : R;
        voffA[i] = (unsigned)(R * K + C) * 2u; voffB[i] = (unsigned)(Rb * K + C) * 2u; }
    const size_t kstep = (size_t)(BK * 2);
    const size_t hstep = (size_t)HALF * K * 2;
    const size_t tstep = 2 * hstep;
    const unsigned ldsw = (unsigned)wid * 1024u;
    const int aoff = lds_byte(wr * 64 + fr, fq * 8), boff = lds_byte(wc * 32 + fr, fq * 8);
#define PG8_SA(b, h) (((b) * 2 + (h)) * HTB)
#define PG8_SB(b, h) ((4 + (b) * 2 + (h)) * HTB)
#define PG8_STAGE(bufoff, gbase, voff) do { _Pragma("unroll") for (int _i = 0; _i < 2; ++_i) \
        __builtin_amdgcn_global_load_lds((const unsigned*)((const char*)(gbase) + (voff)[_i]), (PG8_LAS unsigned*)(lds + (bufoff) + ldsw + _i * 8192), 16, 0, 0); } while (0)
#define PG8_LDA(dst, b, h) do { _Pragma("unroll") for (int m = 0; m < 4; ++m) _Pragma("unroll") for (int k = 0; k < 2; ++k) dst[m][k] = *(const PG8_LAS bf16x8*)(lds + PG8_SA(b, h) + aoff + m * 2048 + k * 1024); } while (0)
#define PG8_LDB(dst, b, h) do { _Pragma("unroll") for (int n = 0; n < 2; ++n) _Pragma("unroll") for (int k = 0; k < 2; ++k) dst[n][k] = *(const PG8_LAS bf16x8*)(lds + PG8_SB(b, h) + boff + n * 2048 + k * 1024); } while (0)
#define PG8_MMA(ai, bj, At, Bt) do { __builtin_amdgcn_s_setprio(1); _Pragma("unroll") for (int m = 0; m < 4; ++m) _Pragma("unroll") for (int n = 0; n < 2; ++n) _Pragma("unroll") for (int k = 0; k < 2; ++k) \
        acc[ai][bj][m][n] = __builtin_amdgcn_mfma_f32_16x16x32_bf16(Bt[n][k], At[m][k], acc[ai][bj][m][n], 0, 0, 0); __builtin_amdgcn_s_setprio(0); } while (0)
#define PG8_WAIT_V(n) asm volatile("s_waitcnt vmcnt(" #n ")" ::: "memory")
#define PG8_WAIT_L(n) asm volatile("s_waitcnt lgkmcnt(" #n ")" ::: "memory")
#define PG8_BAR __builtin_amdgcn_s_barrier()
#define PG8_SCHED __builtin_amdgcn_sched_barrier(0)
    Unit cur, nxt; int ui = 0;
    if (!S.next(0, cur)) return;
    f32x4 acc[2][2][4][2];
#pragma unroll
    for (int a = 0; a < 2; ++a)
#pragma unroll
        for (int b = 0; b < 2; ++b)
#pragma unroll
            for (int m = 0; m < 4; ++m)
#pragma unroll
                for (int n = 0; n < 2; ++n) acc[a][b][m][n] = (f32x4){0.f, 0.f, 0.f, 0.f};
    bf16x8 At[4][2], B0[2][2], B1[2][2];
    const char* cA = (const char*)g.A + (size_t)cur.pm * tstep; const char* cB = (const char*)g.Bt + (size_t)cur.pn * tstep;
    S.a_ready(cur);
    if constexpr (SP2) {
        PG8_STAGE(PG8_SB(0, 0), cB, voffB); PG8_STAGE(PG8_SB(0, 1), cB + hstep, voffB); PG8_STAGE(PG8_SA(0, 0), cA, voffA); PG8_STAGE(PG8_SA(0, 1), cA + hstep, voffA);
        if (wr == 1) PG8_BAR;
        PG8_WAIT_V(2); PG8_BAR;
        PG8_STAGE(PG8_SB(1, 0), cB + kstep, voffB); PG8_STAGE(PG8_SA(1, 0), cA + kstep, voffA); PG8_STAGE(PG8_SB(1, 1), cB + hstep + kstep, voffB);
        PG8_WAIT_V(6); PG8_BAR;
    } else {
        PG8_STAGE(PG8_SB(0, 0), cB, voffB); PG8_STAGE(PG8_SA(0, 0), cA, voffA); PG8_STAGE(PG8_SB(0, 1), cB + hstep, voffB); PG8_STAGE(PG8_SA(0, 1), cA + hstep, voffA);
        if (wr == 1) PG8_BAR;
        PG8_WAIT_V(4); PG8_BAR;
        PG8_STAGE(PG8_SB(1, 0), cB + kstep, voffB); PG8_STAGE(PG8_SA(1, 0), cA + kstep, voffA); PG8_STAGE(PG8_SB(1, 1), cB + hstep + kstep, voffB);
        PG8_WAIT_V(6); PG8_BAR;
    }
    for (;;) {
        const bool has_next = S.next(ui + 1, nxt);
        const char* nA = has_next ? (const char*)g.A + (size_t)nxt.pm * tstep : cA; const char* nB = has_next ? (const char*)g.Bt + (size_t)nxt.pn * tstep : cB;
        for (int t = 0; t < nt; t += 2) {
            const bool last = (t == nt - 2);
            const char* a1 = cA + (size_t)(t + 1) * kstep;
            const char* a2 = last ? nA : cA + (size_t)(t + 2) * kstep; const char* b2 = last ? nB : cB + (size_t)(t + 2) * kstep;
            const char* a3 = a2 + kstep; const char* b3 = b2 + kstep;
            if (last && has_next) S.a_ready(nxt);
            if constexpr (SP2) {
            PG8_LDB(B0, 0, 0); PG8_LDB(B1, 0, 1); PG8_SCHED; PG8_LDA(At, 0, 0); PG8_STAGE(PG8_SA(1, 1), a1 + hstep, voffA);
            PG8_WAIT_V(8); PG8_WAIT_L(0); PG8_BAR; PG8_MMA(0, 0, At, B0); PG8_MMA(0, 1, At, B1); PG8_BAR; PG8_SCHED;
            PG8_LDA(At, 0, 1); PG8_STAGE(PG8_SB(0, 0), b2, voffB); PG8_STAGE(PG8_SB(0, 1), b2 + hstep, voffB); PG8_STAGE(PG8_SA(0, 0), a2, voffA);
            PG8_WAIT_V(8); PG8_WAIT_L(0); PG8_BAR; PG8_MMA(1, 0, At, B0); PG8_MMA(1, 1, At, B1); PG8_BAR; PG8_SCHED;
            PG8_LDB(B0, 1, 0); PG8_LDB(B1, 1, 1); PG8_SCHED; PG8_LDA(At, 1, 0); PG8_STAGE(PG8_SA(0, 1), a2 + hstep, voffA);
            PG8_WAIT_V(8); PG8_WAIT_L(0); PG8_BAR; PG8_MMA(0, 0, At, B0); PG8_MMA(0, 1, At, B1); PG8_BAR; PG8_SCHED;
            PG8_LDA(At, 1, 1); PG8_STAGE(PG8_SB(1, 0), b3, voffB); PG8_STAGE(PG8_SB(1, 1), b3 + hstep, voffB); PG8_STAGE(PG8_SA(1, 0), a3, voffA);
            PG8_WAIT_V(8); PG8_WAIT_L(0); PG8_BAR; PG8_MMA(1, 0, At, B0); PG8_MMA(1, 1, At, B1); PG8_BAR; PG8_SCHED;
            } else {
            PG8_LDB(B0, 0, 0); PG8_SCHED; PG8_LDA(At, 0, 0); PG8_STAGE(PG8_SA(1, 1), a1 + hstep, voffA);
            PG8_WAIT_L(8); PG8_BAR; PG8_WAIT_L(0); PG8_MMA(0, 0, At, B0); PG8_BAR; PG8_SCHED;
            PG8_LDB(B1, 0, 1); PG8_STAGE(PG8_SB(0, 0), b2, voffB);
            PG8_BAR; PG8_WAIT_L(0); PG8_MMA(0, 1, At, B1); PG8_BAR;
            PG8_LDA(At, 0, 1); PG8_STAGE(PG8_SA(0, 0), a2, voffA);
            PG8_BAR; PG8_WAIT_L(0); PG8_MMA(1, 0, At, B0); PG8_BAR; PG8_SCHED;
            PG8_STAGE(PG8_SB(0, 1), b2 + hstep, voffB);
            PG8_WAIT_V(6); PG8_BAR; PG8_MMA(1, 1, At, B1); PG8_BAR;
            PG8_LDB(B0, 1, 0); PG8_SCHED; PG8_LDA(At, 1, 0); PG8_STAGE(PG8_SA(0, 1), a2 + hstep, voffA);
            PG8_WAIT_L(8); PG8_BAR; PG8_WAIT_L(0); PG8_MMA(0, 0, At, B0); PG8_BAR; PG8_SCHED;
            PG8_LDB(B1, 1, 1); PG8_STAGE(PG8_SB(1, 0), b3, voffB);
            PG8_BAR; PG8_WAIT_L(0); PG8_MMA(0, 1, At, B1); PG8_BAR;
            PG8_LDA(At, 1, 1); PG8_STAGE(PG8_SA(1, 0), a3, voffA);
            PG8_BAR; PG8_WAIT_L(0); PG8_MMA(1, 0, At, B0); PG8_BAR; PG8_SCHED;
            PG8_STAGE(PG8_SB(1, 1), b3 + hstep, voffB);
            PG8_WAIT_V(6); PG8_BAR; PG8_MMA(1, 1, At, B1); PG8_BAR;
            }
        }
        if constexpr (ALIGN_EPI) { if (wr == 0) PG8_BAR; }
        if constexpr (!Epi::AFTER_DRAIN) { E(acc, cur, wr, wc, fr, fq); S.done(cur); }
        if (!has_next) break;
#pragma unroll
        for (int a = 0; a < 2; ++a)
#pragma unroll
            for (int b = 0; b < 2; ++b)
#pragma unroll
                for (int m = 0; m < 4; ++m)
#pragma unroll
                    for (int n = 0; n < 2; ++n) acc[a][b][m][n] = (f32x4){0.f, 0.f, 0.f, 0.f};
        cur = nxt; cA = nA; cB = nB; ++ui;
        if constexpr (ALIGN_EPI) { if (wr == 1) PG8_BAR; }
    }
    PG8_WAIT_V(0);
    if constexpr (!ALIGN_EPI) { if (wr == 0) PG8_BAR; }
    PG8_BAR;
#undef PG8_SA
#undef PG8_SB
#undef PG8_STAGE
#undef PG8_LDA
#undef PG8_LDB
#undef PG8_MMA
#undef PG8_WAIT_V
#undef PG8_WAIT_L
#undef PG8_BAR
#undef PG8_SCHED
}
}

struct Args { const float* in[22]; float* out; unsigned char* ws; };
enum { I_X = 0, I_C, I_MODW, I_MODB, I_NMIX, I_NMLP, I_NFIN, I_RGWIN, I_RGCW, I_RGCB, I_RGWA, I_RGBA, I_RGWX, I_RGBX, I_RGLAM, I_RGWOUT, I_HGWIN, I_HGLB, I_HGGN, I_HGWOUT, I_W1, I_W2 };

__device__ __forceinline__ unsigned f2bf(float f) { unsigned u = __builtin_bit_cast(unsigned, f); return (u + 0x7fffu + ((u >> 16) & 1u)) >> 16; }
__device__ __forceinline__ unsigned pk2(float lo, float hi) { return f2bf(lo) | (f2bf(hi) << 16); }
__device__ __forceinline__ void transpose_item(const float* W, int K, int N, bf16_t* WT, LAS float* scr, int item, int lane) {
    const int nblk = N / 32, kb = item / nblk, nb = item % nblk, k0 = 64 * kb, n0 = 32 * nb;
    float tv[32];
#pragma unroll
    for (int i = 0; i < 32; ++i) tv[i] = W[(size_t)(k0 + 2 * i + (lane >> 5)) * N + n0 + (lane & 31)];
#pragma unroll
    for (int i = 0; i < 32; ++i) scr[(2 * i + (lane >> 5)) * 33 + (lane & 31)] = tv[i];
    asm volatile("s_waitcnt lgkmcnt(0)" ::: "memory");
    const int c = lane & 7;
#pragma unroll
    for (int j = 0; j < 4; ++j) { const int n = (lane >> 3) + 8 * j; const LAS float* s = scr + (8 * c) * 33 + n;
        u32x4 o; o.x = pk2(s[0 * 33], s[1 * 33]); o.y = pk2(s[2 * 33], s[3 * 33]); o.z = pk2(s[4 * 33], s[5 * 33]); o.w = pk2(s[6 * 33], s[7 * 33]);
        st16_wt(WT + (size_t)(n0 + n) * K + k0 + 8 * c, o); }
    asm volatile("s_waitcnt lgkmcnt(0)" ::: "memory");
}

__device__ __forceinline__ void prologue(LAS unsigned char* lds, const Args& a, int vcu, int G, int wv) {
    const int tid = opaque_tid(wv), lane = tid & 63, w = tid >> 6;
    unsigned char* ws = a.ws;
    LAS float* CS = (LAS float*)lds;
    LAS float* RED = (LAS float*)(lds + 106496);
    for (int i = tid; i < NB * D; i += 512) { const int b = i >> 10, k = i & 1023; const float cv = a.in[I_C][i]; CS[k * 8 + b] = cv * fsigmoid(cv); }
    LBAR();
    float* mod = (float*)(ws + WS_MOD);
    for (int it = blockIdx.x; it < DEPTH * (MODW / 32); it += G) {
        const int l = it / (MODW / 32), n0 = (it % (MODW / 32)) * 32;
        const float* Wp = a.in[I_MODW] + (size_t)l * D * MODW + n0 + (lane & 31);
        float acc[8];
#pragma unroll
        for (int b = 0; b < 8; ++b) acc[b] = 0.f;
#pragma unroll 32
        for (int i = 0; i < 64; ++i) { const int k = w * 128 + 2 * i + (lane >> 5); const float wv = Wp[(size_t)k * MODW];
            const f32x4 c0 = *(const LAS f32x4*)(CS + k * 8), c1 = *(const LAS f32x4*)(CS + k * 8 + 4);
            acc[0] += c0[0] * wv; acc[1] += c0[1] * wv; acc[2] += c0[2] * wv; acc[3] += c0[3] * wv; acc[4] += c1[0] * wv; acc[5] += c1[1] * wv; acc[6] += c1[2] * wv; acc[7] += c1[3] * wv; }
#pragma unroll
        for (int b = 0; b < 8; ++b) { acc[b] += __shfl_xor(acc[b], 32); if (lane < 32) RED[(w * 8 + b) * 32 + lane] = acc[b]; }
        LBAR();
        if (tid < 256) { const int b = tid >> 5, col = tid & 31; float s = a.in[I_MODB][l * MODW + n0 + col];
#pragma unroll
            for (int ww = 0; ww < 8; ++ww) s += RED[(ww * 8 + b) * 32 + col];
            mod[((size_t)l * NB + b) * MODW + n0 + col] = s; }
        LBAR();
    }
    if (blockIdx.x == 0) { float* LB = (float*)(ws + WS_LB);
        for (int c = tid; c < D; c += 512) { const float v0 = a.in[I_HGLB][c], v1 = a.in[I_HGLB][D + c], v2 = a.in[I_HGLB][2 * D + c], v3 = a.in[I_HGLB][3 * D + c];
            const float mx = fmaxf(fmaxf(v0, v1), fmaxf(v2, v3)); const float e0 = expf(v0 - mx), e1 = expf(v1 - mx), e2 = expf(v2 - mx), e3 = expf(v3 - mx); const float inv = 1.0f / (e0 + e1 + e2 + e3);
            LB[c] = e1 * inv; LB[D + c] = (e1 + e2 + e3) * inv; } }
    LAS float* scr = (LAS float*)(lds + 32768 + w * 8448);
    const int gw = vcu * 8 + w, NGW = G * 8;
    constexpr int I_RGIN = 1024, I_SQ = 512, I_AX = 8, I_BIGW = 2048;
    constexpr int NIT = 2 * I_RGIN + 2 * I_SQ + 32 * I_AX + 2 * I_BIGW + 2 * I_SQ + 4 * I_BIGW + 4 * I_BIGW;
    for (int it = gw; it < NIT; it += NGW) {
        int r = it;
        if (r < 2 * I_RGIN) { const int j = r / I_RGIN; transpose_item(a.in[I_RGWIN] + (size_t)j * D * 2048, D, 2048, (bf16_t*)(ws + W_RGIN) + (size_t)j * 2048 * D, scr, r % I_RGIN, lane); continue; } r -= 2 * I_RGIN;
        if (r < 2 * I_SQ) { const int j = r / I_SQ; transpose_item(a.in[I_RGWOUT] + (size_t)j * D * D, D, D, (bf16_t*)(ws + W_RGOUT) + (size_t)j * D * D, scr, r % I_SQ, lane); continue; } r -= 2 * I_SQ;
        if (r < 32 * I_AX) { const int mi = r / I_AX; const float* src = (mi < 16 ? a.in[I_RGWA] : a.in[I_RGWX]) + (size_t)(mi & 15) * 16384;
            transpose_item(src, 128, 128, (bf16_t*)(ws + W_RGAX) + (size_t)mi * 16384, scr, r % I_AX, lane); continue; } r -= 32 * I_AX;
        if (r < 2 * I_BIGW) { const int j = r / I_BIGW; transpose_item(a.in[I_HGWIN] + (size_t)j * D * FF, D, FF, (bf16_t*)(ws + W_HGIN) + (size_t)j * FF * D, scr, r % I_BIGW, lane); continue; } r -= 2 * I_BIGW;
        if (r < 2 * I_SQ) { const int j = r / I_SQ; transpose_item(a.in[I_HGWOUT] + (size_t)j * D * D, D, D, (bf16_t*)(ws + W_HGOUT) + (size_t)j * D * D, scr, r % I_SQ, lane); continue; } r -= 2 * I_SQ;
        if (r < 4 * I_BIGW) { const int l = r / I_BIGW; transpose_item(a.in[I_W1] + (size_t)l * D * FF, D, FF, (bf16_t*)(ws + W_W1) + (size_t)l * FF * D, scr, r % I_BIGW, lane); continue; } r -= 4 * I_BIGW;
        { const int l = r / I_BIGW; transpose_item(a.in[I_W2] + (size_t)l * FF * D, FF, D, (bf16_t*)(ws + W_W2) + (size_t)l * D * FF, scr, r % I_BIGW, lane); }
    }
}

template <bool FINAL>
__device__ __forceinline__ void norm_phase(const float* x, const float* gain, const float* sh, const float* sc, bf16_t* o16, float* o32, int vcu, int G, int wv) {
    const int tid = opaque_tid(wv), lane = tid & 63, gw = vcu * 8 + __builtin_amdgcn_readfirstlane(tid >> 6), ngw = G * 8;
    for (int r0 = gw * 8; r0 < M; r0 += ngw * 8) {
        const int b = r0 / T;
        f32x4 g[4], s[4];
#pragma unroll
        for (int j = 0; j < 4; ++j) { const int k = 4 * lane + 256 * j; g[j] = *(const f32x4*)(gain + k);
            if (!FINAL) { const f32x4 scv = *(const f32x4*)(sc + (size_t)b * MODW + k); g[j] = g[j] * (1.0f + scv); s[j] = *(const f32x4*)(sh + (size_t)b * MODW + k); } }
#pragma unroll 2
        for (int r = r0; r < r0 + 8; ++r) {
            const f32x4* xr = (const f32x4*)(x + (size_t)r * D) + lane;
            f32x4 v[4]; float ss = 0.f;
#pragma unroll
            for (int j = 0; j < 4; ++j) { v[j] = xr[64 * j]; ss += (v[j][0] * v[j][0] + v[j][1] * v[j][1]) + (v[j][2] * v[j][2] + v[j][3] * v[j][3]); }
            const float rs = rsqrtf(wave_sum(ss) * (1.0f / D) + NORM_EPS);
            if (FINAL) {
                f32x4* op = (f32x4*)(o32 + (size_t)r * D) + lane;
#pragma unroll
                for (int j = 0; j < 4; ++j) op[64 * j] = v[j] * rs * g[j];
            } else {
                u32x2* op = (u32x2*)(o16 + (size_t)r * D) + lane;
#pragma unroll
                for (int j = 0; j < 4; ++j) { const f32x4 y = v[j] * rs * g[j] + s[j]; u32x2 wv; wv.x = cvt_pk_bf16(y[0], y[1]); wv.y = cvt_pk_bf16(y[2], y[3]); op[64 * j] = wv; }
            }
        }
    }
}

__device__ __forceinline__ void norm0_phase(const float* x, const float* gain, const float* sc, bf16_t* o16, float* ss, int vcu, int G, int wv) {
    const int tid = opaque_tid(wv), lane = tid & 63, gw = vcu * 8 + __builtin_amdgcn_readfirstlane(tid >> 6), ngw = G * 8;
    for (int r0 = gw * 8; r0 < M; r0 += ngw * 8) {
        const int b = r0 / T;
        f32x4 g[2][2];
#pragma unroll
        for (int j = 0; j < 2; ++j)
#pragma unroll
            for (int n = 0; n < 2; ++n) { const int k = 8 * lane + 512 * j + 4 * n; g[j][n] = *(const f32x4*)(gain + k) * (1.0f + *(const f32x4*)(sc + (size_t)b * MODW + k)); }
#pragma unroll 4
        for (int r = r0; r < r0 + 8; ++r) {
            const float* xr = x + (size_t)r * D + 8 * lane;
            f32x4 v[2][2]; float sq = 0.f;
#pragma unroll
            for (int j = 0; j < 2; ++j)
#pragma unroll
                for (int n = 0; n < 2; ++n) { v[j][n] = *(const f32x4*)(xr + 512 * j + 4 * n); sq += (v[j][n][0] * v[j][n][0] + v[j][n][1] * v[j][n][1]) + (v[j][n][2] * v[j][n][2] + v[j][n][3] * v[j][n][3]); }
            sq = wave_sum(sq);
#pragma unroll
            for (int j = 0; j < 2; ++j) { const f32x4 y0 = v[j][0] * g[j][0], y1 = v[j][1] * g[j][1];
                st16_wt(o16 + (size_t)r * D + 8 * lane + 512 * j, (u32x4){cvt_pk_bf16(y0[0], y0[1]), cvt_pk_bf16(y0[2], y0[3]), cvt_pk_bf16(y1[0], y1[1]), cvt_pk_bf16(y1[2], y1[3])}); }
            if (lane < 4) *(f32x4*)(ss + (size_t)r * 16 + 4 * lane) = (f32x4){lane == 0 ? sq : 0.f, 0.f, 0.f, 0.f};
        }
    }
}
__device__ __forceinline__ void shw_phase(const Args& a, int vcu, int G, int wv) {
    const int tid = opaque_tid(wv), lane = tid & 63, gw = vcu * 8 + __builtin_amdgcn_readfirstlane(tid >> 6), ngw = G * 8;
    const float* mod = (const float*)(a.ws + WS_MOD); float* shw = (float*)(a.ws + WS_SHW);
    for (int grp = gw; grp < 28672 / 16; grp += ngw) {
        const int c = grp * 16, seg = c >> 11;
        const int gi = (int)((0x77665543322110ull >> (4 * seg)) & 15ull), n0 = c - 2048 * (int)((0xCA875310u >> (4 * gi)) & 15u);
        const int l = gi >> 1;
        const bf16_t* wbase = (gi & 1) ? (const bf16_t*)(a.ws + W_W1) + ((size_t)l * FF + n0) * D
                            : ((l & 1) ? (const bf16_t*)(a.ws + W_HGIN) + ((size_t)(l >> 1) * FF + n0) * D : (const bf16_t*)(a.ws + W_RGIN) + ((size_t)(l >> 1) * 2048 + n0) * D);
        for (int bg = 0; bg < 2; ++bg) {
            f32x4 sh[4][4];
#pragma unroll
            for (int b = 0; b < 4; ++b)
#pragma unroll
                for (int q = 0; q < 4; ++q) sh[b][q] = *(const f32x4*)(mod + ((size_t)l * NB + bg * 4 + b) * MODW + ((gi & 1) ? 3 * D : 0) + lane * 16 + 4 * q);
#pragma unroll 2
            for (int cc = 0; cc < 16; ++cc) {
                const bf16_t* wrow = wbase + (size_t)cc * D;
                const u32x4 w0 = *(const u32x4*)(wrow + lane * 16), w1 = *(const u32x4*)(wrow + lane * 16 + 8);
                const f32x4 wf0 = {bf_lo(w0.x), bf_hi(w0.x), bf_lo(w0.y), bf_hi(w0.y)}, wf1 = {bf_lo(w0.z), bf_hi(w0.z), bf_lo(w0.w), bf_hi(w0.w)};
                const f32x4 wf2 = {bf_lo(w1.x), bf_hi(w1.x), bf_lo(w1.y), bf_hi(w1.y)}, wf3 = {bf_lo(w1.z), bf_hi(w1.z), bf_lo(w1.w), bf_hi(w1.w)};
                float res = 0.f;
#pragma unroll
                for (int b = 0; b < 4; ++b) { const f32x4 p = (sh[b][0] * wf0 + sh[b][1] * wf1) + (sh[b][2] * wf2 + sh[b][3] * wf3); const float t = wave_sum((p[0] + p[1]) + (p[2] + p[3])); if (lane == b) res = t; }
                if (lane < 4) shw[((size_t)gi * 8 + bg * 4 + lane) * 4096 + n0 + cc] = res;
            }
        }
    }
}

__device__ __forceinline__ void rg_phase(LAS unsigned char* lds, const Args& a, int j, int vcu, int G, int wv) {
    const int tid = opaque_tid(wv), lane = tid & 63, w = tid >> 6, lo = lane & 15, fq = lane >> 4;
    LAS bf16_t* XB0 = (LAS bf16_t*)(lds);
    LAS bf16_t* XC = (LAS bf16_t*)(lds + 67584);
    LAS float* WT = (LAS float*)(lds + 102400);
    LAS float* HS = (LAS float*)(lds + 106496);
    LAS float* CW = (LAS float*)(lds + 124928);
    const char* bigb = (const char*)(a.ws + WS_BIG);
    char* a2b = (char*)(a.ws + WS_A2);
    const bf16_t* WAX = (const bf16_t*)(a.ws + W_RGAX);
    const int cg8 = tid & 15, tg = tid >> 4;
    const int otok = tid >> 2, oc8 = (tid & 3) * 8;
    const unsigned tq = (unsigned)((tid >> 4) * 2048 + (tid & 15) * 8) * 2u;
    for (int it = vcu; it < 256; it += G) {
        const int b = it >> 5, h = (it >> 2) & 7, ns = it & 3;
        bf16x8 wf[2][2][4];
#pragma unroll
        for (int gg = 0; gg < 2; ++gg)
#pragma unroll
            for (int ct = 0; ct < 2; ++ct)
#pragma unroll
                for (int ks = 0; ks < 4; ++ks)
                    wf[gg][ct][ks] = *(const bf16x8*)(WAX + (size_t)((gg * 2 + j) * 8 + h) * 16384 + (ns * 32 + ct * 16 + lo) * 128 + ks * 32 + fq * 8);
        float ba[2], bx[2], sp8[2], carry[2];
#pragma unroll
        for (int ct = 0; ct < 2; ++ct) { const int ch = j * D + h * 128 + ns * 32 + ct * 16 + lo; ba[ct] = a.in[I_RGBA][ch]; bx[ct] = a.in[I_RGBX][ch];
            sp8[ct] = 8.0f * log1pf(expf(-a.in[I_RGLAM][ch])); carry[ct] = 0.f; }
        if (tid < 128) {
#pragma unroll
            for (int tap = 0; tap < 4; ++tap) CW[tap * 128 + tid] = a.in[I_RGCW][(size_t)(j * 4 + tap) * D + h * 128 + tid];
            CW[4 * 128 + tid] = a.in[I_RGCB][j * D + h * 128 + tid]; }
        const unsigned xoff = (unsigned)(b * T) * 4096u + (unsigned)(h * 128) * 2u;
        const unsigned goff = (unsigned)(b * T) * 4096u + (unsigned)(1024 + h * 128 + ns * 32 + oc8) * 2u + (unsigned)otok * 4096u;
        const unsigned ooff = (unsigned)(b * T) * 2048u + (unsigned)(h * 128 + ns * 32 + oc8) * 2u + (unsigned)otok * 2048u;
        {
#pragma unroll
            for (int i = 0; i < 4; ++i) { const u32x4 v = *(const u32x4*)(bigb + (size_t)(xoff + (unsigned)(32 * i) * 4096u + tq));
                *(LAS u32x4*)(XB0 + (3 + 32 * i + tg) * 128 + cg8 * 8) = v; }
            if (tid < 48) { unsigned zz = 0u; asm volatile("" : "+v"(zz)); u32x4 z; z.x = zz; z.y = zz; z.z = zz; z.w = zz; *(LAS u32x4*)(XB0 + (tid >> 4) * 128 + (tid & 15) * 8) = z; }
        }
        LBAR();
        for (int tt = 0; tt < 16; ++tt) {
            const int t0 = tt * 128;
            LAS bf16_t* XB = XB0 + (tt & 1) * 16896;
            LAS bf16_t* XBn = XB0 + ((tt + 1) & 1) * 16896;
            LAS float* WTc = WT + (tt & 1) * 512;
            u32x4 nx[4];
            if (tt + 1 < 16) {
#pragma unroll
                for (int i = 0; i < 4; ++i) nx[i] = *(const u32x4*)(bigb + (size_t)(xoff + (unsigned)(t0 + 128 + 32 * i) * 4096u + tq));
            }
            const u32x4 gt = *(const u32x4*)(bigb + (size_t)(goff + (unsigned)t0 * 4096u));
            {
                u32x4 xr[7];
#pragma unroll
                for (int r = 0; r < 7; ++r) xr[r] = *(const LAS u32x4*)(XB + (4 * tg + r) * 128 + cg8 * 8);
                float o[4][8];
                { const f32x4 b0 = *(const LAS f32x4*)(CW + 512 + cg8 * 8), b1 = *(const LAS f32x4*)(CW + 512 + cg8 * 8 + 4);
#pragma unroll
                    for (int tok = 0; tok < 4; ++tok) { o[tok][0] = b0[0]; o[tok][1] = b0[1]; o[tok][2] = b0[2]; o[tok][3] = b0[3]; o[tok][4] = b1[0]; o[tok][5] = b1[1]; o[tok][6] = b1[2]; o[tok][7] = b1[3]; } }
#pragma unroll
                for (int tap = 0; tap < 4; ++tap) { const f32x4 c0 = *(const LAS f32x4*)(CW + tap * 128 + cg8 * 8), c1 = *(const LAS f32x4*)(CW + tap * 128 + cg8 * 8 + 4);
#pragma unroll
                    for (int tok = 0; tok < 4; ++tok) { const u32x4 xv = xr[tok + tap];
                        o[tok][0] += c0[0] * bf_lo(xv.x); o[tok][1] += c0[1] * bf_hi(xv.x); o[tok][2] += c0[2] * bf_lo(xv.y); o[tok][3] += c0[3] * bf_hi(xv.y);
                        o[tok][4] += c1[0] * bf_lo(xv.z); o[tok][5] += c1[1] * bf_hi(xv.z); o[tok][6] += c1[2] * bf_lo(xv.w); o[tok][7] += c1[3] * bf_hi(xv.w); } }
#pragma unroll
                for (int tok = 0; tok < 4; ++tok) { u32x4 pw; pw.x = cvt_pk_bf16(o[tok][0], o[tok][1]); pw.y = cvt_pk_bf16(o[tok][2], o[tok][3]); pw.z = cvt_pk_bf16(o[tok][4], o[tok][5]); pw.w = cvt_pk_bf16(o[tok][6], o[tok][7]);
                    *(LAS u32x4*)(XC + (4 * tg + tok) * 136 + cg8 * 8) = pw; }
            }
            asm volatile("s_waitcnt lgkmcnt(0)" ::: "memory");
            f32x4 accR[2], accI[2];
#pragma unroll
            for (int ct = 0; ct < 2; ++ct) { accR[ct] = (f32x4){0.f, 0.f, 0.f, 0.f}; accI[ct] = (f32x4){0.f, 0.f, 0.f, 0.f}; }
#pragma unroll
            for (int ks = 0; ks < 4; ++ks) { const bf16x8 af = *(const LAS bf16x8*)(XC + (16 * w + lo) * 136 + ks * 32 + fq * 8);
#pragma unroll
                for (int ct = 0; ct < 2; ++ct) { accR[ct] = __builtin_amdgcn_mfma_f32_16x16x32_bf16(af, wf[0][ct][ks], accR[ct], 0, 0, 0);
                    accI[ct] = __builtin_amdgcn_mfma_f32_16x16x32_bf16(af, wf[1][ct][ks], accI[ct], 0, 0, 0); } }
            float av[2][4], uv[2][4], Pe[2], Qe[2];
#pragma unroll
            for (int ct = 0; ct < 2; ++ct) { float P = 1.f, Q = 0.f;
#pragma unroll
                for (int jj = 0; jj < 4; ++jj) { const int tl = 16 * w + 4 * fq + jj;
                    const float xcv = bf1(XC[tl * 136 + ns * 32 + ct * 16 + lo]);
                    const float r = fsigmoid(accR[ct][jj] + ba[ct]), ig = fsigmoid(accI[ct][jj] + bx[ct]);
                    const float la = -sp8[ct] * r; const float aa = fexp(la);
                    const float xx = -2.0f * la; const float m2 = xx < 0.03f ? xx * (1.0f - xx * (0.5f - xx * (0.16666667f - xx * 0.041666667f))) : 1.0f - aa * aa;
                    float mult = __builtin_amdgcn_sqrtf(m2); if (t0 + tl == 0) mult = 1.0f;
                    const float uu = mult * ig * xcv;
                    av[ct][jj] = aa; uv[ct][jj] = uu; Q = aa * Q + uu; P = P * aa; }
                float Pp = __shfl_up(P, 16), Qp = __shfl_up(Q, 16);
                if (fq >= 1) { Q = P * Qp + Q; P = P * Pp; }
                Pp = __shfl_up(P, 32); Qp = __shfl_up(Q, 32);
                if (fq >= 2) { Q = P * Qp + Q; P = P * Pp; }
                Pp = __shfl_up(P, 16); Qp = __shfl_up(Q, 16);
                Pe[ct] = fq >= 1 ? Pp : 1.f; Qe[ct] = fq >= 1 ? Qp : 0.f;
                if (fq == 3) { WTc[(w * 32 + ct * 16 + lo) * 2] = P; WTc[(w * 32 + ct * 16 + lo) * 2 + 1] = Q; } }
            if (tt + 1 < 16) {
#pragma unroll
                for (int i = 0; i < 4; ++i) *(LAS u32x4*)(XBn + (3 + 32 * i + tg) * 128 + cg8 * 8) = nx[i];
                if (tid < 48) { const u32x4 hv = *(const LAS u32x4*)(XB + (128 + (tid >> 4)) * 128 + (tid & 15) * 8); *(LAS u32x4*)(XBn + (tid >> 4) * 128 + (tid & 15) * 8) = hv; }
            }
            LBAR();
#pragma unroll
            for (int ct = 0; ct < 2; ++ct) { float hc = carry[ct], hin = 0.f;
#pragma unroll
                for (int ww = 0; ww < 8; ++ww) { const f32x2 pq = *(const LAS f32x2*)(WTc + (ww * 32 + ct * 16 + lo) * 2); if (ww == w) hin = hc; hc = pq.x * hc + pq.y; }
                carry[ct] = hc;
                float hh = Pe[ct] * hin + Qe[ct];
#pragma unroll
                for (int jj = 0; jj < 4; ++jj) { hh = av[ct][jj] * hh + uv[ct][jj]; HS[(16 * w + 4 * fq + jj) * 36 + ct * 16 + lo] = hh; } }
            asm volatile("s_waitcnt lgkmcnt(0)" ::: "memory");
            {
                const f32x4 h0 = *(const LAS f32x4*)(HS + otok * 36 + oc8), h1 = *(const LAS f32x4*)(HS + otok * 36 + oc8 + 4);
                u32x4 ow; ow.x = cvt_pk_bf16(h0[0] * bf_lo(gt.x), h0[1] * bf_hi(gt.x)); ow.y = cvt_pk_bf16(h0[2] * bf_lo(gt.y), h0[3] * bf_hi(gt.y));
                ow.z = cvt_pk_bf16(h1[0] * bf_lo(gt.z), h1[1] * bf_hi(gt.z)); ow.w = cvt_pk_bf16(h1[2] * bf_lo(gt.w), h1[3] * bf_hi(gt.w));
                st16_wt(a2b + (size_t)(ooff + (unsigned)t0 * 2048u), ow);
            }
            asm volatile("s_waitcnt lgkmcnt(0)" ::: "memory");
        }
        LBAR();
    }
}

__device__ __forceinline__ void hg_phase(LAS unsigned char* lds, const Args& a, int jj_layer, int vcu, int G, int wv, int pass) {
    const int tid = opaque_tid(wv), lane = tid & 63, w = tid >> 6, lo = lane & 15, fq = lane >> 4;
    LAS bf16_t* QT = (LAS bf16_t*)(lds);
    LAS bf16_t* KT = (LAS bf16_t*)(lds + 17408);
    LAS float* OB = (LAS float*)(lds);
    LAS bf16_t* KH = (LAS bf16_t*)(lds + 34816);
    LAS bf16_t* VT = (LAS bf16_t*)(lds + 53248);
    LAS bf16_t* AM = (LAS bf16_t*)(lds + 71680);
    LAS bf16_t* ST = (LAS bf16_t*)(lds + 80896);
    LAS float* ET = (LAS float*)(lds + 115712);
    LAS float* EL = (LAS float*)(lds + 119808);
    const bf16_t* BIG = (const bf16_t*)(a.ws + WS_BIG);
    bf16_t* A2 = (bf16_t*)(a.ws + WS_A2);
    for (int it = vcu; it < 256; it += G) {
        const int b = it >> 5, h = (it >> 2) & 7, q = it & 3;
        const int n_lo = 8 * q, n_end = 8 * q + 8, n_start = pass ? n_lo : n_end;
        if (pass == 0 && q == 3) continue;
        f32x4* dump = (f32x4*)(a.ws + WS_A1);
        const size_t rowbase = (size_t)b * T;
        f32x4 Sacc[8], Dacc = (f32x4){1.f, 1.f, 1.f, 1.f};
#pragma unroll
        for (int vt = 0; vt < 8; ++vt) Sacc[vt] = (f32x4){0.f, 0.f, 0.f, 0.f};
        if (pass) {
            for (int qq = 0; qq < q; ++qq) { const f32x4* dp = dump + ((size_t)((it & ~3) + qq) * 8 + w) * 9 * 64 + lane; const f32x4 dq = dp[8 * 64];
#pragma unroll
                for (int vt = 0; vt < 8; ++vt) Sacc[vt] = Sacc[vt] * dq + dp[vt * 64]; }
#pragma unroll
            for (int vt = 0; vt < 8; ++vt) *(LAS u32x2*)(ST + (16 * vt + lo) * 136 + 16 * w + 4 * fq) = (u32x2){cvt_pk_bf16(Sacc[vt][0], Sacc[vt][1]), cvt_pk_bf16(Sacc[vt][2], Sacc[vt][3])};
        }
        const int otok = tid >> 3, ovc = tid & 7;
        f32x4 gw[4];
#pragma unroll
        for (int i = 0; i < 4; ++i) gw[i] = *(const f32x4*)(a.in[I_HGGN] + jj_layer * 128 + ovc * 16 + 4 * i);
        LBAR();
        unsigned q2[8], k2[8]; u32x4 va, vb;
        const int vsp = tid & 31, vvc = tid >> 5;
#define HG_LOAD_KV(R0) do { _Pragma("unroll") for (int j = 0; j < 8; ++j) k2[j] = *(const unsigned*)(BIG + ((R0) + 8 * w + j) * FF + 1024 + h * 128 + 2 * lane); \
            va = *(const u32x4*)(BIG + ((R0) + 2 * vsp) * FF + 2048 + h * 128 + vvc * 8); vb = *(const u32x4*)(BIG + ((R0) + 2 * vsp + 1) * FF + 2048 + h * 128 + vvc * 8); } while (0)
#define HG_LOAD_Q(R0) do { _Pragma("unroll") for (int j = 0; j < 8; ++j) q2[j] = *(const unsigned*)(BIG + ((R0) + 8 * w + j) * FF + h * 128 + 2 * lane); } while (0)
        HG_LOAD_KV(rowbase + (size_t)n_lo * 64);
        if (pass) HG_LOAD_Q(rowbase + (size_t)n_lo * 64);
        for (int n = n_lo; n < n_end; ++n) {
            const bool full = n >= n_start;
            const size_t r0 = rowbase + (size_t)n * 64;
            u32x4 g0, g1;
            if (full) { g0 = *(const u32x4*)(BIG + (r0 + otok) * FF + 3072 + h * 128 + ovc * 16); g1 = *(const u32x4*)(BIG + (r0 + otok) * FF + 3072 + h * 128 + ovc * 16 + 8); }
            {
                const unsigned vaw[4] = {va.x, va.y, va.z, va.w}, vbw[4] = {vb.x, vb.y, vb.z, vb.w};
#pragma unroll
                for (int i = 0; i < 4; ++i) { const unsigned lo2 = (vaw[i] & 0xffffu) | (vbw[i] << 16), hi2 = (vaw[i] >> 16) | (vbw[i] & 0xffff0000u);
                    *(LAS unsigned*)(VT + (vvc * 8 + 2 * i) * 72 + 2 * vsp) = lo2; *(LAS unsigned*)(VT + (vvc * 8 + 2 * i + 1) * 72 + 2 * vsp) = hi2; }
            }
            float ec[2][8], kk[2][8];
            { float p0 = 1.f, p1 = 1.f;
#pragma unroll
                for (int j = 0; j < 8; ++j) { kk[0][j] = h_lo(k2[j]); kk[1][j] = h_hi(k2[j]); p0 *= (1.0f - kk[0][j]); p1 *= (1.0f - kk[1][j]); ec[0][j] = p0; ec[1][j] = p1; }
                *(LAS f32x2*)(ET + w * 128 + 2 * lane) = (f32x2){p0, p1}; }
            LBAR();
            float es[2] = {1.f, 1.f}, el[2];
            { float r0p = 1.f, r1p = 1.f;
#pragma unroll
                for (int ww = 0; ww < 8; ++ww) { const f32x2 e = *(const LAS f32x2*)(ET + ww * 128 + 2 * lane); if (ww == w) { es[0] = r0p; es[1] = r1p; } r0p *= e.x; r1p *= e.y; }
                el[0] = r0p; el[1] = r1p; }
            if (w == 0) *(LAS f32x2*)(EL + 2 * lane) = (f32x2){el[0], el[1]};
            {
                unsigned khw[2][4];
#pragma unroll
                for (int j = 0; j < 8; ++j) {
                    const float e0 = fmaxf(es[0] * ec[0][j], 1e-30f), e1 = fmaxf(es[1] * ec[1][j], 1e-30f);
                    const float i0 = __builtin_amdgcn_rcpf(e0), i1 = __builtin_amdgcn_rcpf(e1);
                    const float ka = kk[0][j] * i0, kb = kk[1][j] * i1;
                    if (full) { const float qa = bf_lo(q2[j]) * e0, qb = bf_hi(q2[j]) * e1;
                        *(LAS unsigned*)(QT + (8 * w + j) * 136 + 2 * lane) = cvt_pk_bf16(qa, qb);
                        *(LAS unsigned*)(KT + (8 * w + j) * 136 + 2 * lane) = cvt_pk_bf16(ka, kb); }
                    const float ha = ka * el[0], hb = kb * el[1];
                    if (j & 1) { khw[0][j >> 1] = cvt_pk_bf16(ec[0][j - 1], ha); khw[1][j >> 1] = cvt_pk_bf16(ec[1][j - 1], hb); }
                    else { ec[0][j] = ha; ec[1][j] = hb; }
                }
                *(LAS u32x4*)(KH + (2 * lane) * 72 + 8 * w) = (u32x4){khw[0][0], khw[0][1], khw[0][2], khw[0][3]};
                *(LAS u32x4*)(KH + (2 * lane + 1) * 72 + 8 * w) = (u32x4){khw[1][0], khw[1][1], khw[1][2], khw[1][3]};
            }
            LBAR();
            if (n + 1 < n_end) { HG_LOAD_KV(r0 + 64); if (n + 1 >= n_start) HG_LOAD_Q(r0 + 64); }
            f32x4 oacc[4];
            if (full) {
                const int tb = w >> 1;
#pragma unroll
                for (int x = 0; x < 2; ++x) { const int ss = 2 * (w & 1) + x; f32x4 c = (f32x4){0.f, 0.f, 0.f, 0.f};
                    if (ss <= tb) {
#pragma unroll
                        for (int ks = 0; ks < 4; ++ks) { const bf16x8 kf = *(const LAS bf16x8*)(KT + (16 * ss + lo) * 136 + ks * 32 + fq * 8), qf = *(const LAS bf16x8*)(QT + (16 * tb + lo) * 136 + ks * 32 + fq * 8);
                            c = __builtin_amdgcn_mfma_f32_16x16x32_bf16(kf, qf, c, 0, 0, 0); } }
                    const int tq = 16 * tb + lo, s0 = 16 * ss + 4 * fq;
                    float m[4];
#pragma unroll
                    for (int e = 0; e < 4; ++e) m[e] = (s0 + e <= tq) ? c[e] : 0.f;
                    *(LAS u32x2*)(AM + tq * 72 + s0) = (u32x2){cvt_pk_bf16(m[0], m[1]), cvt_pk_bf16(m[2], m[3])}; }
                LBAR();
                const int tb2 = w & 3, vh = w >> 2;
                bf16x8 af[2], qf[4];
#pragma unroll
                for (int ks = 0; ks < 2; ++ks) af[ks] = *(const LAS bf16x8*)(AM + (16 * tb2 + lo) * 72 + ks * 32 + fq * 8);
#pragma unroll
                for (int ks = 0; ks < 4; ++ks) qf[ks] = *(const LAS bf16x8*)(QT + (16 * tb2 + lo) * 136 + ks * 32 + fq * 8);
#pragma unroll
                for (int x = 0; x < 4; ++x) { const int vt = 4 * vh + x; f32x4 c = (f32x4){0.f, 0.f, 0.f, 0.f};
#pragma unroll
                    for (int ks = 0; ks < 2; ++ks) { if (ks == 0 || tb2 >= 2) { const bf16x8 vf = *(const LAS bf16x8*)(VT + (16 * vt + lo) * 72 + ks * 32 + fq * 8); c = __builtin_amdgcn_mfma_f32_16x16x32_bf16(af[ks], vf, c, 0, 0, 0); } }
#pragma unroll
                    for (int ks = 0; ks < 4; ++ks) { const bf16x8 sf = *(const LAS bf16x8*)(ST + (16 * vt + lo) * 136 + ks * 32 + fq * 8); c = __builtin_amdgcn_mfma_f32_16x16x32_bf16(qf[ks], sf, c, 0, 0, 0); }
                    oacc[x] = c; }
            }
            {
                const f32x4 dec = *(const LAS f32x4*)(EL + 16 * w + 4 * fq);
                Dacc = Dacc * dec;
                bf16x8 kf[2];
#pragma unroll
                for (int ks = 0; ks < 2; ++ks) kf[ks] = *(const LAS bf16x8*)(KH + (16 * w + lo) * 72 + ks * 32 + fq * 8);
#pragma unroll
                for (int vt = 0; vt < 8; ++vt) { f32x4 c = Sacc[vt] * dec;
#pragma unroll
                    for (int ks = 0; ks < 2; ++ks) { const bf16x8 vf = *(const LAS bf16x8*)(VT + (16 * vt + lo) * 72 + ks * 32 + fq * 8); c = __builtin_amdgcn_mfma_f32_16x16x32_bf16(kf[ks], vf, c, 0, 0, 0); }
                    Sacc[vt] = c; }
            }
            LBAR();
            if (full) {
#pragma unroll
                for (int vt = 0; vt < 8; ++vt) *(LAS u32x2*)(ST + (16 * vt + lo) * 136 + 16 * w + 4 * fq) = (u32x2){cvt_pk_bf16(Sacc[vt][0], Sacc[vt][1]), cvt_pk_bf16(Sacc[vt][2], Sacc[vt][3])};
            }
            if (full) {
                const int tb2 = w & 3, vh = w >> 2;
#pragma unroll
                for (int x = 0; x < 4; ++x)
#pragma unroll
                    for (int e = 0; e < 4; ++e) OB[(16 * tb2 + 4 * fq + e) * 132 + 16 * (4 * vh + x) + lo] = oacc[x][e];
                LBAR();
                f32x4 ov[4]; float ss = 0.f;
#pragma unroll
                for (int i = 0; i < 4; ++i) { ov[i] = *(const LAS f32x4*)(OB + otok * 132 + ovc * 16 + 4 * i); ss += (ov[i][0] * ov[i][0] + ov[i][1] * ov[i][1]) + (ov[i][2] * ov[i][2] + ov[i][3] * ov[i][3]); }
                ss += __shfl_xor(ss, 1); ss += __shfl_xor(ss, 2); ss += __shfl_xor(ss, 4);
                const float rs = rsqrtf(ss * (1.0f / 128.0f) + GNORM_EPS);
                const unsigned gwd[8] = {g0.x, g0.y, g0.z, g0.w, g1.x, g1.y, g1.z, g1.w};
                unsigned ow[8];
#pragma unroll
                for (int i = 0; i < 4; ++i) { const f32x4 y = ov[i] * rs * gw[i];
                    ow[2 * i] = cvt_pk_bf16(y[0] * bf_lo(gwd[2 * i]), y[1] * bf_hi(gwd[2 * i])); ow[2 * i + 1] = cvt_pk_bf16(y[2] * bf_lo(gwd[2 * i + 1]), y[3] * bf_hi(gwd[2 * i + 1])); }
                bf16_t* op = A2 + (r0 + otok) * D + h * 128 + ovc * 16;
                st16_wt(op, (u32x4){ow[0], ow[1], ow[2], ow[3]}); st16_wt(op + 8, (u32x4){ow[4], ow[5], ow[6], ow[7]});
                LBAR();
            }
        }
        if (!pass) { f32x4* dp = dump + ((size_t)it * 8 + w) * 9 * 64 + lane;
#pragma unroll
            for (int vt = 0; vt < 8; ++vt) dp[vt * 64] = Sacc[vt];
            dp[8 * 64] = Dacc; }
        LBAR();
    }
#undef HG_LOAD_KV
#undef HG_LOAD_Q
}

#define XB_TMO      128
#define XB_XCNT(j)  (256  + 64 * (j))
#define XB_XSUB(j)  (1280 + 64 * (j))
#define XB_XGEN(j)  (2304 + 64 * (j))
#define XB_TOP      3328
#define XB_TOPGEN   3392
#define XCD_BAR_WORDS 3456
#define XB_SPIN_CAP (1u << 18)

__device__ __forceinline__ unsigned xb_ld(unsigned* p)              { return __hip_atomic_load(p, __ATOMIC_RELAXED, __HIP_MEMORY_SCOPE_AGENT); }
__device__ __forceinline__ unsigned xb_add(unsigned* p, unsigned v) { return __hip_atomic_fetch_add(p, v, __ATOMIC_RELAXED, __HIP_MEMORY_SCOPE_AGENT); }
__device__ __forceinline__ unsigned xb_xcc_id() { return (unsigned)__builtin_amdgcn_s_getreg((3 << 11) | 20) & 0xFu; }
#define XB_SPIN(cond, bar) do { unsigned _sp = 0; while (cond) { __builtin_amdgcn_s_sleep(1); \
    if ((++_sp & 255u) == 0u) { if (xb_ld(&(bar)[XB_TMO])) break; if (_sp > XB_SPIN_CAP) { atomicAdd(&(bar)[XB_TMO], 1u); break; } } } } while (0)

struct XcdBarrier {
    unsigned* bar; unsigned x;
    volatile LAS unsigned* st;
};

__device__ __forceinline__ XcdBarrier xcd_barrier_post(unsigned* bar, volatile LAS unsigned* st) {
    XcdBarrier b; b.bar = bar; b.x = xb_xcc_id(); b.st = st;
    if (threadIdx.x == 0) (void)xb_add(&bar[XB_XCNT(b.x)], 1u);
    return b;
}
__device__ __forceinline__ void xcd_barrier_complete(unsigned* bar, unsigned x, unsigned& nloc, unsigned& nx) {
    const unsigned G = gridDim.x * gridDim.y * gridDim.z;
    unsigned sum, cnt, mine, sp = 0u;
    for (;;) {
        sum = 0u; cnt = 0u; mine = 0u;
#pragma unroll
        for (unsigned j = 0; j < 16; ++j) { const unsigned c = xb_ld(&bar[XB_XCNT(j)]); sum += c; cnt += (c > 0u) ? 1u : 0u; mine = (j == x) ? c : mine; }
        if (sum == G) break;
        __builtin_amdgcn_s_sleep(1);
        if ((++sp & 255u) == 0u) { if (xb_ld(&bar[XB_TMO])) break; if (sp > XB_SPIN_CAP) { atomicAdd(&bar[XB_TMO], 1u); break; } }
    }
    nloc = mine > 0u ? mine : 1u; nx = cnt > 0u ? cnt : 1u;
}

__device__ __forceinline__ void xcd_barrier(const XcdBarrier& b) {
    asm volatile("s_waitcnt vmcnt(0)" ::: "memory");
    __syncthreads();
    if (threadIdx.x == 0) {
        unsigned* bar = b.bar;
        __builtin_amdgcn_s_waitcnt(0);
        unsigned nloc = b.st[0], nx = b.st[1];
        if (nloc == 0u) { xcd_barrier_complete(bar, b.x, nloc, nx); b.st[0] = nloc; b.st[1] = nx; }
        const unsigned old = xb_add(&bar[XB_XSUB(b.x)], 1u);
        const unsigned gen = old / nloc;
        if (old + 1u == (gen + 1u) * nloc) {
            __builtin_amdgcn_fence(__ATOMIC_RELEASE, "agent");
            asm volatile("s_waitcnt vmcnt(0)" ::: "memory");
            const unsigned og = xb_add(&bar[XB_TOP], 1u);
            const unsigned tg = og / nx;
            if (og + 1u == (tg + 1u) * nx) xb_add(&bar[XB_TOPGEN], 1u);
            else XB_SPIN(xb_ld(&bar[XB_TOPGEN]) == tg, bar);
            __builtin_amdgcn_fence(__ATOMIC_ACQUIRE, "agent");
            xb_add(&bar[XB_XGEN(b.x)], 1u);
            asm volatile("s_waitcnt vmcnt(0)" ::: "memory");
        } else {
            XB_SPIN(xb_ld(&bar[XB_XGEN(b.x)]) == gen, bar);
            __builtin_amdgcn_fence(__ATOMIC_ACQUIRE, "agent");
            asm volatile("s_waitcnt vmcnt(0)" ::: "memory");
        }
    }
    __syncthreads();
}


#define GRID_SYNC() do { unsigned* _bp = (unsigned*)a.ws; asm volatile("" : "+s"(_bp)); XcdBarrier _xb; _xb.bar = _bp; _xb.x = xb_xcc_id(); _xb.st = (volatile LAS unsigned*)(lds + 131072); xcd_barrier(_xb); } while (0)
__global__ void __launch_bounds__(512, 2) fwd_megakernel(Args a) {
    extern __shared__ __attribute__((aligned(16))) unsigned char lds_raw[];
    LAS unsigned char* lds = (LAS unsigned char*)lds_raw;
    cg::grid_group grid = cg::this_grid();
    const int G = gridDim.x, bx = blockIdx.x;
    const int wv = __builtin_amdgcn_readfirstlane((int)threadIdx.x >> 6);
    const int vcu = (G % 8 == 0) ? (bx % 8) * (G / 8) + bx / 8 : bx;
    unsigned char* ws = a.ws;
    const float* mod = (const float*)(ws + WS_MOD);
    bf16_t* A1 = (bf16_t*)(ws + WS_A1); bf16_t* A2 = (bf16_t*)(ws + WS_A2); bf16_t* BIG = (bf16_t*)(ws + WS_BIG);

    if (threadIdx.x < 2) ((volatile LAS unsigned*)(lds + 131072))[threadIdx.x] = 0u;
    __syncthreads();
    (void)xcd_barrier_post((unsigned*)ws, (volatile LAS unsigned*)(lds + 131072));
    prologue(lds, a, vcu, G, wv);
    if (G > 65535) grid.sync();
    GRID_SYNC();

    const float* xin = a.in[I_X];
    float* SS = (float*)(ws + WS_SS); const float* SHW = (const float*)(ws + WS_SHW);
    norm0_phase(xin, a.in[I_NMIX], mod + 1 * D, A1, SS, vcu, G, wv);
    shw_phase(a, vcu, G, wv);
    GRID_SYNC();
    for (int l = 0; l < DEPTH; ++l) {
        const float* modl = mod + (size_t)l * NB * MODW;
        const int jx = l >> 1;
        if ((l & 1) == 0) {
            { pg8::Gemm g{A1, (const bf16_t*)(ws + W_RGIN) + (size_t)jx * 2048 * D, M, 2048, D}; pg8::StaticOrder S; S.init(M, 2048, G, bx);
              pg8::stage_unit_tables(lds + 131072 + 1024, S, SS, SHW + (size_t)(2 * l) * 8 * 4096, wv);
              pg8::EpiAct<0> E{BIG, 2048, nullptr, lds + 131072 + 1024};
              pg8::gemm_phase<pg8::EpiAct<0>, pg8::StaticOrder, true, true>(lds, g, S, E, wv); }
            GRID_SYNC();
            rg_phase(lds, a, jx, vcu, G, wv);
        } else {
            { pg8::Gemm g{A1, (const bf16_t*)(ws + W_HGIN) + (size_t)jx * FF * D, M, FF, D}; pg8::StaticOrder S; S.init(M, FF, G, bx);
              pg8::stage_unit_tables(lds + 131072 + 1024, S, SS, SHW + (size_t)(2 * l) * 8 * 4096, wv);
              pg8::EpiAct<1> E{BIG, FF, (const float*)(ws + WS_LB) + jx * D, lds + 131072 + 1024};
              pg8::gemm_phase<pg8::EpiAct<1>, pg8::StaticOrder, true, true>(lds, g, S, E, wv); }
            GRID_SYNC();
            hg_phase(lds, a, jx, vcu, G, wv, 0);
            GRID_SYNC();
            hg_phase(lds, a, jx, vcu, G, wv, 1);
        }
        GRID_SYNC();
        { pg8::Gemm g{A2, (l & 1) ? (const bf16_t*)(ws + W_HGOUT) + (size_t)jx * D * D : (const bf16_t*)(ws + W_RGOUT) + (size_t)jx * D * D, M, D, D}; pg8::StaticOrder S; S.init(M, D, G, bx);
          pg8::EpiRes E{xin, a.out, modl + 2 * D, A1, a.in[I_NMLP] + l * D, modl + 4 * D, SS};
          pg8::gemm_phase<pg8::EpiRes, pg8::StaticOrder, true, true>(lds, g, S, E, wv); }
        xin = a.out;
        GRID_SYNC();
        { pg8::Gemm g{A1, (const bf16_t*)(ws + W_W1) + (size_t)l * FF * D, M, FF, D}; pg8::StaticOrder S; S.init(M, FF, G, bx);
          pg8::stage_unit_tables(lds + 131072 + 1024, S, SS, SHW + (size_t)(2 * l + 1) * 8 * 4096, wv);
          pg8::EpiAct<2> E{BIG, FF, nullptr, lds + 131072 + 1024};
          pg8::gemm_phase<pg8::EpiAct<2>, pg8::StaticOrder, true, true>(lds, g, S, E, wv); }
        GRID_SYNC();
        { pg8::Gemm g{BIG, (const bf16_t*)(ws + W_W2) + (size_t)l * D * FF, M, D, FF}; pg8::StaticOrder S; S.init(M, D, G, bx);
          const bool lastl = (l == DEPTH - 1);
          pg8::EpiRes E{xin, a.out, modl + 5 * D, lastl ? nullptr : A1, a.in[I_NMIX] + (lastl ? 0 : (l + 1) * D), mod + (size_t)(lastl ? 0 : (l + 1)) * NB * MODW + 1 * D, SS};
          pg8::gemm_phase<pg8::EpiRes, pg8::StaticOrder, true, true>(lds, g, S, E, wv); }
        GRID_SYNC();
    }
    norm_phase<true>(a.out, a.in[I_NFIN], nullptr, nullptr, nullptr, a.out, vcu, G, wv);
}

extern "C" void kernel_launch(void* const* d_in, const int* in_sizes, int n_in, void* d_out, int out_size, void* d_ws, size_t ws_size, hipStream_t stream) {
    static int grid = 0;
    if (grid == 0) {
        if (n_in != 22 || out_size != M * D || ws_size < WS_END) { fprintf(stderr, "kernel_launch: unexpected shapes (n_in %d out %d ws %zu)\n", n_in, out_size, ws_size); grid = -1; return; }
        int dev = 0, cus = 0, per_cu = 0;
        hipGetDevice(&dev);
        hipDeviceGetAttribute(&cus, hipDeviceAttributeMultiprocessorCount, dev);
        hipFuncSetAttribute((const void*)fwd_megakernel, hipFuncAttributeMaxDynamicSharedMemorySize, LDS_BYTES);
        hipOccupancyMaxActiveBlocksPerMultiprocessor(&per_cu, (const void*)fwd_megakernel, 512, LDS_BYTES);
        if (per_cu < 1) { fprintf(stderr, "kernel_launch: occupancy query says %d blocks/CU\n", per_cu); per_cu = 1; }
        (void)hipGetLastError();
        grid = cus;
    }
    if (grid < 0) return;
    (void)hipMemsetAsync(d_ws, 0, 16384, stream);
    Args a{};
    for (int i = 0; i < 22; ++i) a.in[i] = (const float*)d_in[i];
    a.out = (float*)d_out; a.ws = (unsigned char*)d_ws;
    void* args[] = {&a};
    hipError_t e = hipLaunchCooperativeKernel((const void*)fwd_megakernel, dim3(grid), dim3(512), args, LDS_BYTES, stream);
    if (e != hipSuccess) fprintf(stderr, "cooperative launch failed: %s (grid %d)\n", hipGetErrorString(e), grid);
}
```

```cpp
#include <hip/hip_runtime.h>
#include <hip/hip_cooperative_groups.h>
#include <cstdio>
#include <cstdint>
namespace cg = cooperative_groups;

#define LAS __attribute__((address_space(3)))
typedef unsigned short bf16_t;
typedef short bf16x8 __attribute__((ext_vector_type(8)));
typedef float f32x4 __attribute__((ext_vector_type(4)));
typedef float f32x2 __attribute__((ext_vector_type(2)));
typedef unsigned u32x4 __attribute__((ext_vector_type(4)));
typedef unsigned u32x2 __attribute__((ext_vector_type(2)));

constexpr int NB = 8, T = 2048, D = 1024, M = NB * T, FF = 4096, DEPTH = 4;
constexpr int MODW = 6 * D;
constexpr float NORM_EPS = 1e-6f, GNORM_EPS = 1e-5f;

constexpr size_t MiB = 1u << 20;
constexpr size_t WS_MOD = 1 * MiB;
constexpr size_t WS_LB = WS_MOD + 768 * 1024;
constexpr size_t WS_W = 2 * MiB;
constexpr size_t W_RGIN = WS_W + 0 * MiB, W_RGOUT = WS_W + 8 * MiB, W_RGAX = WS_W + 12 * MiB, W_HGIN = WS_W + 13 * MiB, W_HGOUT = WS_W + 29 * MiB,
                 W_W1 = WS_W + 33 * MiB, W_W2 = WS_W + 65 * MiB;
constexpr size_t WS_A1 = 100 * MiB;
constexpr size_t WS_A2 = 132 * MiB;
constexpr size_t WS_BIG = 164 * MiB;
constexpr size_t WS_SS = 292 * MiB;
constexpr size_t WS_SHW = 293 * MiB;
constexpr size_t WS_XB = 296 * MiB;
constexpr size_t WS_XL = 328 * MiB;
constexpr size_t WS_END = 344 * MiB;

constexpr int LDS_BYTES = 147456;

#define LBAR() do { asm volatile("s_waitcnt lgkmcnt(0)" ::: "memory"); __builtin_amdgcn_s_barrier(); asm volatile("" ::: "memory"); } while (0)
typedef __bf16 bf16x2_t __attribute__((ext_vector_type(2)));
__device__ __forceinline__ unsigned cvt_pk_bf16(float lo, float hi) { f32x2 v = {lo, hi}; bf16x2_t b = __builtin_convertvector(v, bf16x2_t); return __builtin_bit_cast(unsigned, b); }
__device__ __forceinline__ void st16_wt(void* p, u32x4 v) { *(u32x4*)p = v; }
__device__ __forceinline__ void st16_wt(void* p, f32x4 v) { *(f32x4*)p = v; }
__device__ __forceinline__ unsigned r24(float f) { return __builtin_bit_cast(unsigned, f) + 0x80u; }
__device__ __forceinline__ void pack24(const f32x4& a, const f32x4& b, u32x4& hi, u32x2& lo) {
    const unsigned w0 = r24(a[0]), w1 = r24(a[1]), w2 = r24(a[2]), w3 = r24(a[3]), w4 = r24(b[0]), w5 = r24(b[1]), w6 = r24(b[2]), w7 = r24(b[3]);
    hi.x = __builtin_amdgcn_perm(w1, w0, 0x07060302u); hi.y = __builtin_amdgcn_perm(w3, w2, 0x07060302u); hi.z = __builtin_amdgcn_perm(w5, w4, 0x07060302u); hi.w = __builtin_amdgcn_perm(w7, w6, 0x07060302u);
    lo.x = __builtin_amdgcn_perm(__builtin_amdgcn_perm(w3, w2, 0x00000501u), __builtin_amdgcn_perm(w1, w0, 0x00000501u), 0x05040100u);
    lo.y = __builtin_amdgcn_perm(__builtin_amdgcn_perm(w7, w6, 0x00000501u), __builtin_amdgcn_perm(w5, w4, 0x00000501u), 0x05040100u);
}
__device__ __forceinline__ void unpack24(const u32x4& hi, const u32x2& lo, f32x4& a, f32x4& b) {
    a[0] = __builtin_bit_cast(float, (hi.x << 16) | ((lo.x & 0xffu) << 8));          a[1] = __builtin_bit_cast(float, (hi.x & 0xffff0000u) | (lo.x & 0xff00u));
    a[2] = __builtin_bit_cast(float, (hi.y << 16) | ((lo.x >> 8) & 0xff00u));        a[3] = __builtin_bit_cast(float, (hi.y & 0xffff0000u) | ((lo.x >> 16) & 0xff00u));
    b[0] = __builtin_bit_cast(float, (hi.z << 16) | ((lo.y & 0xffu) << 8));          b[1] = __builtin_bit_cast(float, (hi.z & 0xffff0000u) | (lo.y & 0xff00u));
    b[2] = __builtin_bit_cast(float, (hi.w << 16) | ((lo.y >> 8) & 0xff00u));        b[3] = __builtin_bit_cast(float, (hi.w & 0xffff0000u) | ((lo.y >> 16) & 0xff00u));
}
__device__ __forceinline__ float bf_lo(unsigned w) { return __builtin_bit_cast(float, w << 16); }
__device__ __forceinline__ float bf_hi(unsigned w) { return __builtin_bit_cast(float, w & 0xffff0000u); }
__device__ __forceinline__ float bf1(bf16_t v) { return __builtin_bit_cast(float, (unsigned)v << 16); }
__device__ __forceinline__ unsigned pk_f16(float lo, float hi) { typedef _Float16 h2 __attribute__((ext_vector_type(2))); h2 v; v.x = (_Float16)lo; v.y = (_Float16)hi; return __builtin_bit_cast(unsigned, v); }
__device__ __forceinline__ float h_lo(unsigned w) { typedef _Float16 h2 __attribute__((ext_vector_type(2))); h2 v = __builtin_bit_cast(h2, w); return (float)v.x; }
__device__ __forceinline__ float h_hi(unsigned w) { typedef _Float16 h2 __attribute__((ext_vector_type(2))); h2 v = __builtin_bit_cast(h2, w); return (float)v.y; }
__device__ __forceinline__ float fexp(float x) { return __builtin_amdgcn_exp2f(x * 1.4426950408889634f); }
__device__ __forceinline__ float fsigmoid(float x) { return __builtin_amdgcn_rcpf(1.0f + __builtin_amdgcn_exp2f(x * -1.4426950408889634f)); }
__device__ __forceinline__ int opaque_tid(int wv) { int t; asm volatile("v_mbcnt_lo_u32_b32 %0, -1, 0\n\tv_mbcnt_hi_u32_b32 %0, -1, %0" : "=v"(t)); return (wv << 6) + t; }
__device__ __forceinline__ float wave_sum(float v) {
#pragma unroll
    for (int o = 1; o < 64; o <<= 1) v += __shfl_xor(v, o);
    return v;
}

namespace pg8 {
#define PG8_LAS __attribute__((address_space(3)))
constexpr int BM = 256, BK = 64, HALF = 128, HTB = HALF * BK * 2, STAGE_BYTES = 8 * HTB, NXCD = 8, WGM = 8;
__host__ __device__ __forceinline__ int lds_byte(int r, int c) { const int st = (r >> 4) * 2 + (c >> 5), rr = r & 15, cc = c & 31, ob = rr * 64 + cc * 2; return st * 1024 + (ob ^ (((ob >> 9) & 1) << 5)); }
__host__ __device__ __forceinline__ void stage_rc(int b, int& R, int& C) { const int st = b / 1024, sb = b % 1024, swz = sb ^ (((sb >> 9) & 1) << 5); R = (st >> 1) * 16 + swz / 64; C = (st & 1) * 32 + (swz % 64) / 2; }
__host__ __device__ __forceinline__ int perm32(int rho) { const int n = rho >> 4, i = rho & 15; return 8 * (i >> 2) + 4 * n + (i & 3); }

struct Unit { int pm, pn, idx; };
struct Gemm { const bf16_t* A; const bf16_t* Bt; int M, N, K; };
struct StaticOrder {
    int nM, nN, nwg, G, c;
    __host__ __device__ void init(int M_, int N_, int G_, int c_) { nM = M_ / BM; nN = N_ / BM; nwg = nM * nN; G = G_; c = c_; }
    __host__ __device__ bool next(int i, Unit& u) const {
        const long L = (long)i * G + c; if (L >= nwg) return false;
        int wgid = (int)L; { const int q = nwg / NXCD, r = nwg % NXCD, xcd = wgid % NXCD, off = wgid / NXCD; wgid = (xcd < r ? xcd * (q + 1) : r * (q + 1) + (xcd - r) * q) + off; }
        const int nig = WGM * nN, gid = wgid / nig, fm = gid * WGM, gsz = (nM - fm) < WGM ? (nM - fm) : WGM;
        u.pm = fm + ((wgid % nig) % gsz); u.pn = (wgid % nig) / gsz; u.idx = i; return true;
    }
    __device__ __forceinline__ void a_ready(const Unit&) const {}
    __device__ __forceinline__ void done(const Unit&) const {}
};

template <int MODE> struct EpiAct {
    static constexpr bool PERM = true, AFTER_DRAIN = false;
    bf16_t* O; int ldc; const float* lb; PG8_LAS unsigned char* tab;
    __device__ __forceinline__ void operator()(const f32x4 (&acc)[2][2][4][2], const Unit& u, int wr, int wc, int fr, int fq) const {
        const int row0 = u.pm * BM + wr * 64 + fr; const int colt = u.pn * BM; const int blk = colt >> 10;
        const int col0 = colt + wc * 32 + 8 * fq;
        float rsv[8];
        { PG8_LAS const float* rt = (PG8_LAS const float*)(tab + u.idx * 2048) + wr * 64 + fr;
#pragma unroll
            for (int i = 0; i < 8; ++i) rsv[i] = rt[(i >> 2) * HALF + (i & 3) * 16]; }
        f32x4 sw[2][2];
        { PG8_LAS const float* st = (PG8_LAS const float*)(tab + u.idx * 2048 + 1024) + wc * 32 + 8 * fq;
#pragma unroll
            for (int bj = 0; bj < 2; ++bj)
#pragma unroll
                for (int n = 0; n < 2; ++n) sw[bj][n] = *(PG8_LAS const f32x4*)(st + bj * HALF + 4 * n); }
        f32x4 om[2][2];
        if (MODE == 1) {
#pragma unroll
            for (int bj = 0; bj < 2; ++bj)
#pragma unroll
                for (int n = 0; n < 2; ++n) { om[bj][n] = (f32x4){0.f, 0.f, 0.f, 0.f};
                    if (blk == 1) { const f32x4 l = *(const f32x4*)(lb + (col0 - 1024) + bj * HALF + 4 * n); om[bj][n] = 1.0f - l; } }
        }
#pragma unroll
        for (int ai = 0; ai < 2; ++ai)
#pragma unroll
            for (int m = 0; m < 4; ++m) { bf16_t* rowp = O + (size_t)(row0 + ai * HALF + m * 16) * ldc + col0;
#pragma unroll
                for (int bj = 0; bj < 2; ++bj) { f32x4 v[2] = {acc[ai][bj][m][0] * rsv[ai * 4 + m] + sw[bj][0], acc[ai][bj][m][1] * rsv[ai * 4 + m] + sw[bj][1]}; u32x4 w;
                    if (MODE == 0) {
                        if (blk == 1) {
#pragma unroll
                            for (int n = 0; n < 2; ++n)
#pragma unroll
                                for (int e = 0; e < 4; ++e) { const float x = v[n][e]; const float z = 1.5957691216f * (x + 0.044715f * x * x * x); v[n][e] = x * fsigmoid(z); }
                        }
                        w.x = cvt_pk_bf16(v[0][0], v[0][1]); w.y = cvt_pk_bf16(v[0][2], v[0][3]); w.z = cvt_pk_bf16(v[1][0], v[1][1]); w.w = cvt_pk_bf16(v[1][2], v[1][3]);
                    } else if (MODE == 1) {
                        if (blk == 1) {
#pragma unroll
                            for (int n = 0; n < 2; ++n)
#pragma unroll
                                for (int e = 0; e < 4; ++e) v[n][e] = om[bj][n][e] * fsigmoid(-v[n][e]);
                            w.x = pk_f16(v[0][0], v[0][1]); w.y = pk_f16(v[0][2], v[0][3]); w.z = pk_f16(v[1][0], v[1][1]); w.w = pk_f16(v[1][2], v[1][3]);
                        } else {
                            if (blk != 2) {
#pragma unroll
                                for (int n = 0; n < 2; ++n)
#pragma unroll
                                    for (int e = 0; e < 4; ++e) v[n][e] = v[n][e] * fsigmoid(v[n][e]);
                            }
                            w.x = cvt_pk_bf16(v[0][0], v[0][1]); w.y = cvt_pk_bf16(v[0][2], v[0][3]); w.z = cvt_pk_bf16(v[1][0], v[1][1]); w.w = cvt_pk_bf16(v[1][2], v[1][3]);
                        }
                    } else {
#pragma unroll
                        for (int n = 0; n < 2; ++n)
#pragma unroll
                            for (int e = 0; e < 4; ++e) { const float x = fmaxf(v[n][e], 0.f); v[n][e] = x * x; }
                        w.x = cvt_pk_bf16(v[0][0], v[0][1]); w.y = cvt_pk_bf16(v[0][2], v[0][3]); w.z = cvt_pk_bf16(v[1][0], v[1][1]); w.w = cvt_pk_bf16(v[1][2], v[1][3]);
                    }
                    st16_wt(rowp + bj * HALF, w); } }
    }
};
template <bool XIN32> struct EpiRes {
    static constexpr bool PERM = true, AFTER_DRAIN = false;
    const float* xin32; const bf16_t* xin16; const unsigned char* xin8; bf16_t* xout; unsigned char* xout8; const float* gate;
    bf16_t* a1; const float* gain; const float* sc; float* ss;
    __device__ __forceinline__ void operator()(const f32x4 (&acc)[2][2][4][2], const Unit& u, int wr, int wc, int fr, int fq) const {
        const int b = (u.pm * BM) / T; const int col0 = u.pn * BM + wc * 32 + 8 * fq;
        f32x4 gv[2][2], gn[2][2];
#pragma unroll
        for (int bj = 0; bj < 2; ++bj)
#pragma unroll
            for (int n = 0; n < 2; ++n) { gv[bj][n] = *(const f32x4*)(gate + (size_t)b * MODW + col0 + bj * HALF + n * 4);
                if (a1) { const f32x4 g0 = *(const f32x4*)(gain + col0 + bj * HALF + n * 4), s0 = *(const f32x4*)(sc + (size_t)b * MODW + col0 + bj * HALF + n * 4); gn[bj][n] = g0 * (1.0f + s0); } }
#pragma unroll
        for (int ai = 0; ai < 2; ++ai)
#pragma unroll
            for (int m = 0; m < 4; ++m) { const int row = u.pm * BM + ai * HALF + wr * 64 + m * 16 + fr; const size_t off = (size_t)row * D + col0; float sq = 0.f;
#pragma unroll
                for (int bj = 0; bj < 2; ++bj) { f32x4 xi[2], xn[2];
                    if (XIN32) { xi[0] = *(const f32x4*)(xin32 + off + bj * HALF); xi[1] = *(const f32x4*)(xin32 + off + bj * HALF + 4); }
                    else { const u32x4 rh = *(const u32x4*)(xin16 + off + bj * HALF); const u32x2 rl = *(const u32x2*)(xin8 + off + bj * HALF); unpack24(rh, rl, xi[0], xi[1]); }
#pragma unroll
                    for (int n = 0; n < 2; ++n) xn[n] = xi[n] + gv[bj][n] * acc[ai][bj][m][n];
                    { u32x4 ph; u32x2 pl; pack24(xn[0], xn[1], ph, pl); st16_wt(xout + off + bj * HALF, ph); *(u32x2*)(xout8 + off + bj * HALF) = pl; }
                    if (a1) { sq += ((xn[0][0] * xn[0][0] + xn[0][1] * xn[0][1]) + (xn[0][2] * xn[0][2] + xn[0][3] * xn[0][3])) + ((xn[1][0] * xn[1][0] + xn[1][1] * xn[1][1]) + (xn[1][2] * xn[1][2] + xn[1][3] * xn[1][3]));
                        const f32x4 y0 = xn[0] * gn[bj][0], y1 = xn[1] * gn[bj][1];
                        st16_wt(a1 + off + bj * HALF, (u32x4){cvt_pk_bf16(y0[0], y0[1]), cvt_pk_bf16(y0[2], y0[3]), cvt_pk_bf16(y1[0], y1[1]), cvt_pk_bf16(y1[2], y1[3])}); } }
                if (a1) { sq += __shfl_xor(sq, 16); sq += __shfl_xor(sq, 32); if (fq == 0) ss[(size_t)row * 16 + u.pn * 4 + wc] = sq; }
                if (m & 1) asm volatile("" ::: "memory"); }
    }
};

template <class Sched>
__device__ __forceinline__ void stage_unit_tables(PG8_LAS unsigned char* tab, const Sched& S, const float* ss, const float* shw, int wv) {
    const int tid = opaque_tid(wv);
    Unit u;
    for (int i = 0; S.next(i, u); ++i) {
        PG8_LAS float* t = (PG8_LAS float*)(tab + i * 2048);
        if (tid < 256) { const f32x4* sp = (const f32x4*)(ss + (size_t)(u.pm * BM + tid) * 16); const f32x4 sm = (sp[0] + sp[1]) + (sp[2] + sp[3]);
            t[tid] = rsqrtf(((sm[0] + sm[1]) + (sm[2] + sm[3])) * (1.0f / D) + NORM_EPS); }
        else t[tid] = shw[(size_t)((u.pm * BM) / T) * 4096 + u.pn * BM + (tid - 256)];
    }
    asm volatile("s_waitcnt vmcnt(0) lgkmcnt(0)" ::: "memory"); __builtin_amdgcn_s_barrier(); asm volatile("" ::: "memory");
}

template <class Epi, class Sched, bool ALIGN_EPI = false, bool SP2 = false>
__device__ __forceinline__ void gemm_phase(PG8_LAS unsigned char* lds, const Gemm g, const Sched& S, const Epi& E, int wv) {
    const int tid = opaque_tid(wv), wid = __builtin_amdgcn_readfirstlane(tid >> 6), lane = tid & 63, wr = wid >> 2, wc = wid & 3, fr = lane & 15, fq = lane >> 4;
    const int K = g.K, nt = K / BK;
    unsigned voffA[2], voffB[2];
#pragma unroll
    for (int i = 0; i < 2; ++i) { int R, C; stage_rc(tid * 16 + i * 8192, R, C); const int Rb = Epi::PERM ? ((R & ~31) + perm32(R & 31)) : R;
        voffA[i] = (unsigned)(R * K + C) * 2u; voffB[i] = (unsigned)(Rb * K + C) * 2u; }
    const size_t kstep = (size_t)(BK * 2);
    const size_t hstep = (size_t)HALF * K * 2;
    const size_t tstep = 2 * hstep;
    const unsigned ldsw = (unsigned)wid * 1024u;
    const int aoff = lds_byte(wr * 64 + fr, fq * 8), boff = lds_byte(wc * 32 + fr, fq * 8);
#define PG8_SA(b, h) (((b) * 2 + (h)) * HTB)
#define PG8_SB(b, h) ((4 + (b) * 2 + (h)) * HTB)
#define PG8_STAGE(bufoff, gbase, voff) do { _Pragma("unroll") for (int _i = 0; _i < 2; ++_i) \
        __builtin_amdgcn_global_load_lds((const unsigned*)((const char*)(gbase) + (voff)[_i]), (PG8_LAS unsigned*)(lds + (bufoff) + ldsw + _i * 8192), 16, 0, 0); } while (0)
#define PG8_LDA(dst, b, h) do { _Pragma("unroll") for (int m = 0; m < 4; ++m) _Pragma("unroll") for (int k = 0; k < 2; ++k) dst[m][k] = *(const PG8_LAS bf16x8*)(lds + PG8_SA(b, h) + aoff + m * 2048 + k * 1024); } while (0)
#define PG8_LDB(dst, b, h) do { _Pragma("unroll") for (int n = 0; n < 2; ++n) _Pragma("unroll") for (int k = 0; k < 2; ++k) dst[n][k] = *(const PG8_LAS bf16x8*)(lds + PG8_SB(b, h) + boff + n * 2048 + k * 1024); } while (0)
#define PG8_MMA(ai, bj, At, Bt) do { __builtin_amdgcn_s_setprio(1); _Pragma("unroll") for (int m = 0; m < 4; ++m) _Pragma("unroll") for (int n = 0; n < 2; ++n) _Pragma("unroll") for (int k = 0; k < 2; ++k) \
        acc[ai][bj][m][n] = __builtin_amdgcn_mfma_f32_16x16x32_bf16(Bt[n][k], At[m][k], acc[ai][bj][m][n], 0, 0, 0); __builtin_amdgcn_s_setprio(0); } while (0)
#define PG8_WAIT_V(n) asm volatile("s_waitcnt vmcnt(" #n ")" ::: "memory")
#define PG8_WAIT_L(n) asm volatile("s_waitcnt lgkmcnt(" #n ")" ::: "memory")
#define PG8_BAR __builtin_amdgcn_s_barrier()
#define PG8_SCHED __builtin_amdgcn_sched_barrier(0)
    Unit cur, nxt; int ui = 0;
    if (!S.next(0, cur)) return;
    f32x4 acc[2][2][4][2];
#pragma unroll
    for (int a = 0; a < 2; ++a)
#pragma unroll
        for (int b = 0; b < 2; ++b)
#pragma unroll
            for (int m = 0; m < 4; ++m)
#pragma unroll
                for (int n = 0; n < 2; ++n) acc[a][b][m][n] = (f32x4){0.f, 0.f, 0.f, 0.f};
    bf16x8 At[4][2], B0[2][2], B1[2][2];
    const char* cA = (const char*)g.A + (size_t)cur.pm * tstep; const char* cB = (const char*)g.Bt + (size_t)cur.pn * tstep;
    S.a_ready(cur);
    if constexpr (SP2) {
        PG8_STAGE(PG8_SB(0, 0), cB, voffB); PG8_STAGE(PG8_SB(0, 1), cB + hstep, voffB); PG8_STAGE(PG8_SA(0, 0), cA, voffA); PG8_STAGE(PG8_SA(0, 1), cA + hstep, voffA);
        if (wr == 1) PG8_BAR;
        PG8_WAIT_V(2); PG8_BAR;
        PG8_STAGE(PG8_SB(1, 0), cB + kstep, voffB); PG8_STAGE(PG8_SA(1, 0), cA + kstep, voffA); PG8_STAGE(PG8_SB(1, 1), cB + hstep + kstep, voffB);
        PG8_WAIT_V(6); PG8_BAR;
    } else {
        PG8_STAGE(PG8_SB(0, 0), cB, voffB); PG8_STAGE(PG8_SA(0, 0), cA, voffA); PG8_STAGE(PG8_SB(0, 1), cB + hstep, voffB); PG8_STAGE(PG8_SA(0, 1), cA + hstep, voffA);
        if (wr == 1) PG8_BAR;
        PG8_WAIT_V(4); PG8_BAR;
        PG8_STAGE(PG8_SB(1, 0), cB + kstep, voffB); PG8_STAGE(PG8_SA(1, 0), cA + kstep, voffA); PG8_STAGE(PG8_SB(1, 1), cB + hstep + kstep, voffB);
        PG8_WAIT_V(6); PG8_BAR;
    }
    for (;;) {
        const bool has_next = S.next(ui + 1, nxt);
        const char* nA = has_next ? (const char*)g.A + (size_t)nxt.pm * tstep : cA; const char* nB = has_next ? (const char*)g.Bt + (size_t)nxt.pn * tstep : cB;
        for (int t = 0; t < nt; t += 2) {
            const bool last = (t == nt - 2);
            const char* a1 = cA + (size_t)(t + 1) * kstep;
            const char* a2 = last ? nA : cA + (size_t)(t + 2) * kstep; const char* b2 = last ? nB : cB + (size_t)(t + 2) * kstep;
            const char* a3 = a2 + kstep; const char* b3 = b2 + kstep;
            if (last && has_next) S.a_ready(nxt);
            if constexpr (SP2) {
            PG8_LDB(B0, 0, 0); PG8_LDB(B1, 0, 1); PG8_SCHED; PG8_LDA(At, 0, 0); PG8_STAGE(PG8_SA(1, 1), a1 + hstep, voffA);
            PG8_WAIT_V(8); PG8_WAIT_L(0); PG8_BAR; PG8_MMA(0, 0, At, B0); PG8_MMA(0, 1, At, B1); PG8_BAR; PG8_SCHED;
            PG8_LDA(At, 0, 1); PG8_STAGE(PG8_SB(0, 0), b2, voffB); PG8_STAGE(PG8_SB(0, 1), b2 + hstep, voffB); PG8_STAGE(PG8_SA(0, 0), a2, voffA);
            PG8_WAIT_V(8); PG8_WAIT_L(0); PG8_BAR; PG8_MMA(1, 0, At, B0); PG8_MMA(1, 1, At, B1); PG8_BAR; PG8_SCHED;
            PG8_LDB(B0, 1, 0); PG8_LDB(B1, 1, 1); PG8_SCHED; PG8_LDA(At, 1, 0); PG8_STAGE(PG8_SA(0, 1), a2 + hstep, voffA);
            PG8_WAIT_V(8); PG8_WAIT_L(0); PG8_BAR; PG8_MMA(0, 0, At, B0); PG8_MMA(0, 1, At, B1); PG8_BAR; PG8_SCHED;
            PG8_LDA(At, 1, 1); PG8_STAGE(PG8_SB(1, 0), b3, voffB); PG8_STAGE(PG8_SB(1, 1), b3 + hstep, voffB); PG8_STAGE(PG8_SA(1, 0), a3, voffA);
            PG8_WAIT_V(8); PG8_WAIT_L(0); PG8_BAR; PG8_MMA(1, 0, At, B0); PG8_MMA(1, 1, At, B1); PG8_BAR; PG8_SCHED;
            } else {
            PG8_LDB(B0, 0, 0); PG8_SCHED; PG8_LDA(At, 0, 0); PG8_STAGE(PG8_SA(1, 1), a1 + hstep, voffA);
            PG8_WAIT_L(8); PG8_BAR; PG8_WAIT_L(0); PG8_MMA(0, 0, At, B0); PG8_BAR; PG8_SCHED;
            PG8_LDB(B1, 0, 1); PG8_STAGE(PG8_SB(0, 0), b2, voffB);
            PG8_BAR; PG8_WAIT_L(0); PG8_MMA(0, 1, At, B1); PG8_BAR;
            PG8_LDA(At, 0, 1); PG8_STAGE(PG8_SA(0, 0), a2, voffA);
            PG8_BAR; PG8_WAIT_L(0); PG8_MMA(1, 0, At, B0); PG8_BAR; PG8_SCHED;
            PG8_STAGE(PG8_SB(0, 1), b2 + hstep, voffB);
            PG8_WAIT_V(6); PG8_BAR; PG8_MMA(1, 1, At, B1); PG8_BAR;
            PG8_LDB(B0, 1, 0); PG8_SCHED; PG8_LDA(At, 1, 0); PG8_STAGE(PG8_SA(0, 1), a2 + hstep, voffA);
            PG8_WAIT_L(8); PG8_BAR; PG8_WAIT_L(0); PG8_MMA(0, 0, At, B0); PG8_BAR; PG8_SCHED;
            PG8_LDB(B1, 1, 1); PG8_STAGE(PG8_SB(1, 0), b3, voffB);
            PG8_BAR; PG8_WAIT_L(0); PG8_MMA(0, 1, At, B1); PG8_BAR;
            PG8_LDA(At, 1, 1); PG8_STAGE(PG8_SA(1, 0), a3, voffA);
            PG8_BAR; PG8_WAIT_L(0); PG8_MMA(1, 0, At, B0); PG8_BAR; PG8_SCHED;
            PG8_STAGE(PG8_SB(1, 1), b3 + hstep, voffB);
            PG8_WAIT_V(6); PG8_BAR; PG8_MMA(1, 1, At, B1); PG8_BAR;
            }
        }
        if constexpr (ALIGN_EPI) { if (wr == 0) PG8_BAR; }
        if constexpr (!Epi::AFTER_DRAIN) { E(acc, cur, wr, wc, fr, fq); S.done(cur); }
        if (!has_next) break;
#pragma unroll
        for (int a = 0; a < 2; ++a)
#pragma unroll
            for (int b = 0; b < 2; ++b)
#pragma unroll
                for (int m = 0; m < 4; ++m)
#pragma unroll
                    for (int n = 0; n < 2; ++n) acc[a][b][m][n] = (f32x4){0.f, 0.f, 0.f, 0.f};
        cur = nxt; cA = nA; cB = nB; ++ui;
        if constexpr (ALIGN_EPI) { if (wr == 1) PG8_BAR; }
    }
    PG8_WAIT_V(0);
    if constexpr (!ALIGN_EPI) { if (wr == 0) PG8_BAR; }
    PG8_BAR;
#undef PG8_SA
#undef PG8_SB
#undef PG8_STAGE
#undef PG8_LDA
#undef PG8_LDB
#undef PG8_MMA
#undef PG8_WAIT_V
#undef PG8_WAIT_L
#undef PG8_BAR
#undef PG8_SCHED
}
}

struct Args { const float* in[22]; float* out; unsigned char* ws; };
enum { I_X = 0, I_C, I_MODW, I_MODB, I_NMIX, I_NMLP, I_NFIN, I_RGWIN, I_RGCW, I_RGCB, I_RGWA, I_RGBA, I_RGWX, I_RGBX, I_RGLAM, I_RGWOUT, I_HGWIN, I_HGLB, I_HGGN, I_HGWOUT, I_W1, I_W2 };

__device__ __forceinline__ unsigned f2bf(float f) { unsigned u = __builtin_bit_cast(unsigned, f); return (u + 0x7fffu + ((u >> 16) & 1u)) >> 16; }
__device__ __forceinline__ unsigned pk2(float lo, float hi) { return f2bf(lo) | (f2bf(hi) << 16); }
__device__ __forceinline__ void transpose_item(const float* W, int K, int N, bf16_t* WT, LAS float* scr, int item, int lane) {
    const int nblk = N / 32, kb = item / nblk, nb = item % nblk, k0 = 64 * kb, n0 = 32 * nb;
    float tv[32];
#pragma unroll
    for (int i = 0; i < 32; ++i) tv[i] = W[(size_t)(k0 + 2 * i + (lane >> 5)) * N + n0 + (lane & 31)];
#pragma unroll
    for (int i = 0; i < 32; ++i) scr[(2 * i + (lane >> 5)) * 33 + (lane & 31)] = tv[i];
    asm volatile("s_waitcnt lgkmcnt(0)" ::: "memory");
    const int c = lane & 7;
#pragma unroll
    for (int j = 0; j < 4; ++j) { const int n = (lane >> 3) + 8 * j; const LAS float* s = scr + (8 * c) * 33 + n;
        u32x4 o; o.x = pk2(s[0 * 33], s[1 * 33]); o.y = pk2(s[2 * 33], s[3 * 33]); o.z = pk2(s[4 * 33], s[5 * 33]); o.w = pk2(s[6 * 33], s[7 * 33]);
        st16_wt(WT + (size_t)(n0 + n) * K + k0 + 8 * c, o); }
    asm volatile("s_waitcnt lgkmcnt(0)" ::: "memory");
}

__device__ __forceinline__ void prologue(LAS unsigned char* lds, const Args& a, int vcu, int G, int wv) {
    const int tid = opaque_tid(wv), lane = tid & 63, w = tid >> 6;
    unsigned char* ws = a.ws;
    LAS float* CS = (LAS float*)lds;
    LAS float* RED = (LAS float*)(lds + 106496);
    for (int i = tid; i < NB * D; i += 512) { const int b = i >> 10, k = i & 1023; const float cv = a.in[I_C][i]; CS[k * 8 + b] = cv * fsigmoid(cv); }
    LBAR();
    float* mod = (float*)(ws + WS_MOD);
    for (int it = blockIdx.x; it < DEPTH * (MODW / 32); it += G) {
        const int l = it / (MODW / 32), n0 = (it % (MODW / 32)) * 32;
        const float* Wp = a.in[I_MODW] + (size_t)l * D * MODW + n0 + (lane & 31);
        float acc[8];
#pragma unroll
        for (int b = 0; b < 8; ++b) acc[b] = 0.f;
#pragma unroll 32
        for (int i = 0; i < 64; ++i) { const int k = w * 128 + 2 * i + (lane >> 5); const float wv = Wp[(size_t)k * MODW];
            const f32x4 c0 = *(const LAS f32x4*)(CS + k * 8), c1 = *(const LAS f32x4*)(CS + k * 8 + 4);
            acc[0] += c0[0] * wv; acc[1] += c0[1] * wv; acc[2] += c0[2] * wv; acc[3] += c0[3] * wv; acc[4] += c1[0] * wv; acc[5] += c1[1] * wv; acc[6] += c1[2] * wv; acc[7] += c1[3] * wv; }
#pragma unroll
        for (int b = 0; b < 8; ++b) { acc[b] += __shfl_xor(acc[b], 32); if (lane < 32) RED[(w * 8 + b) * 32 + lane] = acc[b]; }
        LBAR();
        if (tid < 256) { const int b = tid >> 5, col = tid & 31; float s = a.in[I_MODB][l * MODW + n0 + col];
#pragma unroll
            for (int ww = 0; ww < 8; ++ww) s += RED[(ww * 8 + b) * 32 + col];
            mod[((size_t)l * NB + b) * MODW + n0 + col] = s; }
        LBAR();
    }
    if (blockIdx.x == 0) { float* LB = (float*)(ws + WS_LB);
        for (int c = tid; c < D; c += 512) { const float v0 = a.in[I_HGLB][c], v1 = a.in[I_HGLB][D + c], v2 = a.in[I_HGLB][2 * D + c], v3 = a.in[I_HGLB][3 * D + c];
            const float mx = fmaxf(fmaxf(v0, v1), fmaxf(v2, v3)); const float e0 = expf(v0 - mx), e1 = expf(v1 - mx), e2 = expf(v2 - mx), e3 = expf(v3 - mx); const float inv = 1.0f / (e0 + e1 + e2 + e3);
            LB[c] = e1 * inv; LB[D + c] = (e1 + e2 + e3) * inv; } }
    LAS float* scr = (LAS float*)(lds + 32768 + w * 8448);
    const int gw = vcu * 8 + w, NGW = G * 8;
    constexpr int I_RGIN = 1024, I_SQ = 512, I_AX = 8, I_BIGW = 2048;
    constexpr int NIT = 2 * I_RGIN + 2 * I_SQ + 32 * I_AX + 2 * I_BIGW + 2 * I_SQ + 4 * I_BIGW + 4 * I_BIGW;
    for (int it = gw; it < NIT; it += NGW) {
        int r = it;
        if (r < 2 * I_RGIN) { const int j = r / I_RGIN; transpose_item(a.in[I_RGWIN] + (size_t)j * D * 2048, D, 2048, (bf16_t*)(ws + W_RGIN) + (size_t)j * 2048 * D, scr, r % I_RGIN, lane); continue; } r -= 2 * I_RGIN;
        if (r < 2 * I_SQ) { const int j = r / I_SQ; transpose_item(a.in[I_RGWOUT] + (size_t)j * D * D, D, D, (bf16_t*)(ws + W_RGOUT) + (size_t)j * D * D, scr, r % I_SQ, lane); continue; } r -= 2 * I_SQ;
        if (r < 32 * I_AX) { const int mi = r / I_AX; const float* src = (mi < 16 ? a.in[I_RGWA] : a.in[I_RGWX]) + (size_t)(mi & 15) * 16384;
            transpose_item(src, 128, 128, (bf16_t*)(ws + W_RGAX) + (size_t)mi * 16384, scr, r % I_AX, lane); continue; } r -= 32 * I_AX;
        if (r < 2 * I_BIGW) { const int j = r / I_BIGW; transpose_item(a.in[I_HGWIN] + (size_t)j * D * FF, D, FF, (bf16_t*)(ws + W_HGIN) + (size_t)j * FF * D, scr, r % I_BIGW, lane); continue; } r -= 2 * I_BIGW;
        if (r < 2 * I_SQ) { const int j = r / I_SQ; transpose_item(a.in[I_HGWOUT] + (size_t)j * D * D, D, D, (bf16_t*)(ws + W_HGOUT) + (size_t)j * D * D, scr, r % I_SQ, lane); continue; } r -= 2 * I_SQ;
        if (r < 4 * I_BIGW) { const int l = r / I_BIGW; transpose_item(a.in[I_W1] + (size_t)l * D * FF, D, FF, (bf16_t*)(ws + W_W1) + (size_t)l * FF * D, scr, r % I_BIGW, lane); continue; } r -= 4 * I_BIGW;
        { const int l = r / I_BIGW; transpose_item(a.in[I_W2] + (size_t)l * FF * D, FF, D, (bf16_t*)(ws + W_W2) + (size_t)l * D * FF, scr, r % I_BIGW, lane); }
    }
}

__device__ __forceinline__ void final_norm_phase(const bf16_t* x, const unsigned char* x8, const float* gain, float* out, int vcu, int G, int wv) {
    const int tid = opaque_tid(wv), lane = tid & 63, gw = vcu * 8 + __builtin_amdgcn_readfirstlane(tid >> 6), ngw = G * 8;
    for (int r0 = gw * 8; r0 < M; r0 += ngw * 8) {
        f32x4 g[2][2];
#pragma unroll
        for (int j = 0; j < 2; ++j)
#pragma unroll
            for (int n = 0; n < 2; ++n) g[j][n] = *(const f32x4*)(gain + 8 * lane + 512 * j + 4 * n);
#pragma unroll 4
        for (int r = r0; r < r0 + 8; ++r) {
            f32x4 v[2][2]; float sq = 0.f;
#pragma unroll
            for (int j = 0; j < 2; ++j) { const u32x4 w4 = *(const u32x4*)(x + (size_t)r * D + 8 * lane + 512 * j);
                const u32x2 l2 = *(const u32x2*)(x8 + (size_t)r * D + 8 * lane + 512 * j); unpack24(w4, l2, v[j][0], v[j][1]);
#pragma unroll
                for (int n = 0; n < 2; ++n) sq += (v[j][n][0] * v[j][n][0] + v[j][n][1] * v[j][n][1]) + (v[j][n][2] * v[j][n][2] + v[j][n][3] * v[j][n][3]); }
            const float rs = rsqrtf(wave_sum(sq) * (1.0f / D) + NORM_EPS);
#pragma unroll
            for (int j = 0; j < 2; ++j)
#pragma unroll
                for (int n = 0; n < 2; ++n) *(f32x4*)(out + (size_t)r * D + 8 * lane + 512 * j + 4 * n) = v[j][n] * rs * g[j][n];
        }
    }
}

__device__ __forceinline__ void norm0_phase(const float* x, const float* gain, const float* sc, bf16_t* o16, float* ss, int vcu, int G, int wv) {
    const int tid = opaque_tid(wv), lane = tid & 63, gw = vcu * 8 + __builtin_amdgcn_readfirstlane(tid >> 6), ngw = G * 8;
    for (int r0 = gw * 8; r0 < M; r0 += ngw * 8) {
        const int b = r0 / T;
        f32x4 g[2][2];
#pragma unroll
        for (int j = 0; j < 2; ++j)
#pragma unroll
            for (int n = 0; n < 2; ++n) { const int k = 8 * lane + 512 * j + 4 * n; g[j][n] = *(const f32x4*)(gain + k) * (1.0f + *(const f32x4*)(sc + (size_t)b * MODW + k)); }
#pragma unroll 4
        for (int r = r0; r < r0 + 8; ++r) {
            const float* xr = x + (size_t)r * D + 8 * lane;
            f32x4 v[2][2]; float sq = 0.f;
#pragma unroll
            for (int j = 0; j < 2; ++j)
#pragma unroll
                for (int n = 0; n < 2; ++n) { v[j][n] = *(const f32x4*)(xr + 512 * j + 4 * n); sq += (v[j][n][0] * v[j][n][0] + v[j][n][1] * v[j][n][1]) + (v[j][n][2] * v[j][n][2] + v[j][n][3] * v[j][n][3]); }
            sq = wave_sum(sq);
#pragma unroll
            for (int j = 0; j < 2; ++j) { const f32x4 y0 = v[j][0] * g[j][0], y1 = v[j][1] * g[j][1];
                st16_wt(o16 + (size_t)r * D + 8 * lane + 512 * j, (u32x4){cvt_pk_bf16(y0[0], y0[1]), cvt_pk_bf16(y0[2], y0[3]), cvt_pk_bf16(y1[0], y1[1]), cvt_pk_bf16(y1[2], y1[3])}); }
            if (lane < 4) *(f32x4*)(ss + (size_t)r * 16 + 4 * lane) = (f32x4){lane == 0 ? sq : 0.f, 0.f, 0.f, 0.f};
        }
    }
}
__device__ __forceinline__ void shw_phase(const Args& a, int vcu, int G, int wv) {
    const int tid = opaque_tid(wv), lane = tid & 63, gw = vcu * 8 + __builtin_amdgcn_readfirstlane(tid >> 6), ngw = G * 8;
    const float* mod = (const float*)(a.ws + WS_MOD); float* shw = (float*)(a.ws + WS_SHW);
    for (int grp = gw; grp < 28672 / 16; grp += ngw) {
        const int c = grp * 16, seg = c >> 11;
        const int gi = (int)((0x77665543322110ull >> (4 * seg)) & 15ull), n0 = c - 2048 * (int)((0xCA875310u >> (4 * gi)) & 15u);
        const int l = gi >> 1;
        const bf16_t* wbase = (gi & 1) ? (const bf16_t*)(a.ws + W_W1) + ((size_t)l * FF + n0) * D
                            : ((l & 1) ? (const bf16_t*)(a.ws + W_HGIN) + ((size_t)(l >> 1) * FF + n0) * D : (const bf16_t*)(a.ws + W_RGIN) + ((size_t)(l >> 1) * 2048 + n0) * D);
        for (int bg = 0; bg < 2; ++bg) {
            f32x4 sh[4][4];
#pragma unroll
            for (int b = 0; b < 4; ++b)
#pragma unroll
                for (int q = 0; q < 4; ++q) sh[b][q] = *(const f32x4*)(mod + ((size_t)l * NB + bg * 4 + b) * MODW + ((gi & 1) ? 3 * D : 0) + lane * 16 + 4 * q);
#pragma unroll 2
            for (int cc = 0; cc < 16; ++cc) {
                const bf16_t* wrow = wbase + (size_t)cc * D;
                const u32x4 w0 = *(const u32x4*)(wrow + lane * 16), w1 = *(const u32x4*)(wrow + lane * 16 + 8);
                const f32x4 wf0 = {bf_lo(w0.x), bf_hi(w0.x), bf_lo(w0.y), bf_hi(w0.y)}, wf1 = {bf_lo(w0.z), bf_hi(w0.z), bf_lo(w0.w), bf_hi(w0.w)};
                const f32x4 wf2 = {bf_lo(w1.x), bf_hi(w1.x), bf_lo(w1.y), bf_hi(w1.y)}, wf3 = {bf_lo(w1.z), bf_hi(w1.z), bf_lo(w1.w), bf_hi(w1.w)};
                float res = 0.f;
#pragma unroll
                for (int b = 0; b < 4; ++b) { const f32x4 p = (sh[b][0] * wf0 + sh[b][1] * wf1) + (sh[b][2] * wf2 + sh[b][3] * wf3); const float t = wave_sum((p[0] + p[1]) + (p[2] + p[3])); if (lane == b) res = t; }
                if (lane < 4) shw[((size_t)gi * 8 + bg * 4 + lane) * 4096 + n0 + cc] = res;
            }
        }
    }
}

__device__ __forceinline__ void rg_phase(LAS unsigned char* lds, const Args& a, int j, int vcu, int G, int wv) {
    const int tid = opaque_tid(wv), lane = tid & 63, w = tid >> 6, lo = lane & 15, fq = lane >> 4;
    LAS bf16_t* XB0 = (LAS bf16_t*)(lds);
    LAS bf16_t* XC = (LAS bf16_t*)(lds + 67584);
    LAS float* WT = (LAS float*)(lds + 102400);
    LAS float* HS = (LAS float*)(lds + 106496);
    LAS float* CW = (LAS float*)(lds + 124928);
    const char* bigb = (const char*)(a.ws + WS_BIG);
    char* a2b = (char*)(a.ws + WS_A2);
    const bf16_t* WAX = (const bf16_t*)(a.ws + W_RGAX);
    const int cg8 = tid & 15, tg = tid >> 4;
    const int otok = tid >> 2, oc8 = (tid & 3) * 8;
    const unsigned tq = (unsigned)((tid >> 4) * 2048 + (tid & 15) * 8) * 2u;
    for (int it = vcu; it < 256; it += G) {
        const int b = it >> 5, h = (it >> 2) & 7, ns = it & 3;
        bf16x8 wf[2][2][4];
#pragma unroll
        for (int gg = 0; gg < 2; ++gg)
#pragma unroll
            for (int ct = 0; ct < 2; ++ct)
#pragma unroll
                for (int ks = 0; ks < 4; ++ks)
                    wf[gg][ct][ks] = *(const bf16x8*)(WAX + (size_t)((gg * 2 + j) * 8 + h) * 16384 + (ns * 32 + ct * 16 + lo) * 128 + ks * 32 + fq * 8);
        float ba[2], bx[2], sp8[2], carry[2];
#pragma unroll
        for (int ct = 0; ct < 2; ++ct) { const int ch = j * D + h * 128 + ns * 32 + ct * 16 + lo; ba[ct] = a.in[I_RGBA][ch]; bx[ct] = a.in[I_RGBX][ch];
            sp8[ct] = 8.0f * log1pf(expf(-a.in[I_RGLAM][ch])); carry[ct] = 0.f; }
        if (tid < 128) {
#pragma unroll
            for (int tap = 0; tap < 4; ++tap) CW[tap * 128 + tid] = a.in[I_RGCW][(size_t)(j * 4 + tap) * D + h * 128 + tid];
            CW[4 * 128 + tid] = a.in[I_RGCB][j * D + h * 128 + tid]; }
        const unsigned xoff = (unsigned)(b * T) * 4096u + (unsigned)(h * 128) * 2u;
        const unsigned goff = (unsigned)(b * T) * 4096u + (unsigned)(1024 + h * 128 + ns * 32 + oc8) * 2u + (unsigned)otok * 4096u;
        const unsigned ooff = (unsigned)(b * T) * 2048u + (unsigned)(h * 128 + ns * 32 + oc8) * 2u + (unsigned)otok * 2048u;
        {
#pragma unroll
            for (int i = 0; i < 4; ++i) { const u32x4 v = *(const u32x4*)(bigb + (size_t)(xoff + (unsigned)(32 * i) * 4096u + tq));
                *(LAS u32x4*)(XB0 + (3 + 32 * i + tg) * 128 + cg8 * 8) = v; }
            if (tid < 48) { unsigned zz = 0u; asm volatile("" : "+v"(zz)); u32x4 z; z.x = zz; z.y = zz; z.z = zz; z.w = zz; *(LAS u32x4*)(XB0 + (tid >> 4) * 128 + (tid & 15) * 8) = z; }
        }
        LBAR();
        for (int tt = 0; tt < 16; ++tt) {
            const int t0 = tt * 128;
            LAS bf16_t* XB = XB0 + (tt & 1) * 16896;
            LAS bf16_t* XBn = XB0 + ((tt + 1) & 1) * 16896;
            LAS float* WTc = WT + (tt & 1) * 512;
            u32x4 nx[4];
            if (tt + 1 < 16) {
#pragma unroll
                for (int i = 0; i < 4; ++i) nx[i] = *(const u32x4*)(bigb + (size_t)(xoff + (unsigned)(t0 + 128 + 32 * i) * 4096u + tq));
            }
            const u32x4 gt = *(const u32x4*)(bigb + (size_t)(goff + (unsigned)t0 * 4096u));
            {
                u32x4 xr[7];
#pragma unroll
                for (int r = 0; r < 7; ++r) xr[r] = *(const LAS u32x4*)(XB + (4 * tg + r) * 128 + cg8 * 8);
                float o[4][8];
                { const f32x4 b0 = *(const LAS f32x4*)(CW + 512 + cg8 * 8), b1 = *(const LAS f32x4*)(CW + 512 + cg8 * 8 + 4);
#pragma unroll
                    for (int tok = 0; tok < 4; ++tok) { o[tok][0] = b0[0]; o[tok][1] = b0[1]; o[tok][2] = b0[2]; o[tok][3] = b0[3]; o[tok][4] = b1[0]; o[tok][5] = b1[1]; o[tok][6] = b1[2]; o[tok][7] = b1[3]; } }
#pragma unroll
                for (int tap = 0; tap < 4; ++tap) { const f32x4 c0 = *(const LAS f32x4*)(CW + tap * 128 + cg8 * 8), c1 = *(const LAS f32x4*)(CW + tap * 128 + cg8 * 8 + 4);
#pragma unroll
                    for (int tok = 0; tok < 4; ++tok) { const u32x4 xv = xr[tok + tap];
                        o[tok][0] += c0[0] * bf_lo(xv.x); o[tok][1] += c0[1] * bf_hi(xv.x); o[tok][2] += c0[2] * bf_lo(xv.y); o[tok][3] += c0[3] * bf_hi(xv.y);
                        o[tok][4] += c1[0] * bf_lo(xv.z); o[tok][5] += c1[1] * bf_hi(xv.z); o[tok][6] += c1[2] * bf_lo(xv.w); o[tok][7] += c1[3] * bf_hi(xv.w); } }
#pragma unroll
                for (int tok = 0; tok < 4; ++tok) { u32x4 pw; pw.x = cvt_pk_bf16(o[tok][0], o[tok][1]); pw.y = cvt_pk_bf16(o[tok][2], o[tok][3]); pw.z = cvt_pk_bf16(o[tok][4], o[tok][5]); pw.w = cvt_pk_bf16(o[tok][6], o[tok][7]);
                    *(LAS u32x4*)(XC + (4 * tg + tok) * 136 + cg8 * 8) = pw; }
            }
            asm volatile("s_waitcnt lgkmcnt(0)" ::: "memory");
            f32x4 accR[2], accI[2];
#pragma unroll
            for (int ct = 0; ct < 2; ++ct) { accR[ct] = (f32x4){0.f, 0.f, 0.f, 0.f}; accI[ct] = (f32x4){0.f, 0.f, 0.f, 0.f}; }
#pragma unroll
            for (int ks = 0; ks < 4; ++ks) { const bf16x8 af = *(const LAS bf16x8*)(XC + (16 * w + lo) * 136 + ks * 32 + fq * 8);
#pragma unroll
                for (int ct = 0; ct < 2; ++ct) { accR[ct] = __builtin_amdgcn_mfma_f32_16x16x32_bf16(af, wf[0][ct][ks], accR[ct], 0, 0, 0);
                    accI[ct] = __builtin_amdgcn_mfma_f32_16x16x32_bf16(af, wf[1][ct][ks], accI[ct], 0, 0, 0); } }
            float av[2][4], uv[2][4], Pe[2], Qe[2];
#pragma unroll
            for (int ct = 0; ct < 2; ++ct) { float P = 1.f, Q = 0.f;
#pragma unroll
                for (int jj = 0; jj < 4; ++jj) { const int tl = 16 * w + 4 * fq + jj;
                    const float xcv = bf1(XC[tl * 136 + ns * 32 + ct * 16 + lo]);
                    const float r = fsigmoid(accR[ct][jj] + ba[ct]), ig = fsigmoid(accI[ct][jj] + bx[ct]);
                    const float la = -sp8[ct] * r; const float aa = fexp(la);
                    const float xx = -2.0f * la; const float m2 = xx < 0.03f ? xx * (1.0f - xx * (0.5f - xx * (0.16666667f - xx * 0.041666667f))) : 1.0f - aa * aa;
                    float mult = __builtin_amdgcn_sqrtf(m2); if (t0 + tl == 0) mult = 1.0f;
                    const float uu = mult * ig * xcv;
                    av[ct][jj] = aa; uv[ct][jj] = uu; Q = aa * Q + uu; P = P * aa; }
                float Pp = __shfl_up(P, 16), Qp = __shfl_up(Q, 16);
                if (fq >= 1) { Q = P * Qp + Q; P = P * Pp; }
                Pp = __shfl_up(P, 32); Qp = __shfl_up(Q, 32);
                if (fq >= 2) { Q = P * Qp + Q; P = P * Pp; }
                Pp = __shfl_up(P, 16); Qp = __shfl_up(Q, 16);
                Pe[ct] = fq >= 1 ? Pp : 1.f; Qe[ct] = fq >= 1 ? Qp : 0.f;
                if (fq == 3) { WTc[(w * 32 + ct * 16 + lo) * 2] = P; WTc[(w * 32 + ct * 16 + lo) * 2 + 1] = Q; } }
            if (tt + 1 < 16) {
#pragma unroll
                for (int i = 0; i < 4; ++i) *(LAS u32x4*)(XBn + (3 + 32 * i + tg) * 128 + cg8 * 8) = nx[i];
                if (tid < 48) { const u32x4 hv = *(const LAS u32x4*)(XB + (128 + (tid >> 4)) * 128 + (tid & 15) * 8); *(LAS u32x4*)(XBn + (tid >> 4) * 128 + (tid & 15) * 8) = hv; }
            }
            LBAR();
#pragma unroll
            for (int ct = 0; ct < 2; ++ct) { float hc = carry[ct], hin = 0.f;
#pragma unroll
                for (int ww = 0; ww < 8; ++ww) { const f32x2 pq = *(const LAS f32x2*)(WTc + (ww * 32 + ct * 16 + lo) * 2); if (ww == w) hin = hc; hc = pq.x * hc + pq.y; }
                carry[ct] = hc;
                float hh = Pe[ct] * hin + Qe[ct];
#pragma unroll
                for (int jj = 0; jj < 4; ++jj) { hh = av[ct][jj] * hh + uv[ct][jj]; HS[(16 * w + 4 * fq + jj) * 36 + ct * 16 + lo] = hh; } }
            asm volatile("s_waitcnt lgkmcnt(0)" ::: "memory");
            {
                const f32x4 h0 = *(const LAS f32x4*)(HS + otok * 36 + oc8), h1 = *(const LAS f32x4*)(HS + otok * 36 + oc8 + 4);
                u32x4 ow; ow.x = cvt_pk_bf16(h0[0] * bf_lo(gt.x), h0[1] * bf_hi(gt.x)); ow.y = cvt_pk_bf16(h0[2] * bf_lo(gt.y), h0[3] * bf_hi(gt.y));
                ow.z = cvt_pk_bf16(h1[0] * bf_lo(gt.z), h1[1] * bf_hi(gt.z)); ow.w = cvt_pk_bf16(h1[2] * bf_lo(gt.w), h1[3] * bf_hi(gt.w));
                st16_wt(a2b + (size_t)(ooff + (unsigned)t0 * 2048u), ow);
            }
            asm volatile("s_waitcnt lgkmcnt(0)" ::: "memory");
        }
        LBAR();
    }
}

__device__ __forceinline__ void hg_phase(LAS unsigned char* lds, const Args& a, int jj_layer, int vcu, int G, int wv) {
    const int tid = opaque_tid(wv), lane = tid & 63, w = tid >> 6, lo = lane & 15, fq = lane >> 4;
    LAS bf16_t* QT = (LAS bf16_t*)(lds);
    LAS bf16_t* KT = (LAS bf16_t*)(lds + 17408);
    LAS float* OB = (LAS float*)(lds);
    LAS bf16_t* KH = (LAS bf16_t*)(lds + 34816);
    LAS bf16_t* VT = (LAS bf16_t*)(lds + 53248);
    LAS bf16_t* AM = (LAS bf16_t*)(lds + 71680);
    LAS bf16_t* ST = (LAS bf16_t*)(lds + 80896);
    LAS float* ET = (LAS float*)(lds + 115712);
    LAS float* EL = (LAS float*)(lds + 119808);
    const bf16_t* BIG = (const bf16_t*)(a.ws + WS_BIG);
    bf16_t* A2 = (bf16_t*)(a.ws + WS_A2);
    for (int it = vcu; it < 256; it += G) {
        const int b = it >> 5, h = (it >> 2) & 7, q = it & 3;
        const int n_start = (int)((0x1C170E00u >> (8 * q)) & 255u), n_end = (q == 3) ? 32 : (int)((0x1C170E00u >> (8 * q + 8)) & 255u);
        const size_t rowbase = (size_t)b * T;
        f32x4 Sacc[8];
#pragma unroll
        for (int vt = 0; vt < 8; ++vt) Sacc[vt] = (f32x4){0.f, 0.f, 0.f, 0.f};
        for (int i = tid; i < 128 * 136 / 2; i += 512) ((LAS unsigned*)ST)[i] = 0u;
        const int otok = tid >> 3, ovc = tid & 7;
        f32x4 gw[4];
#pragma unroll
        for (int i = 0; i < 4; ++i) gw[i] = *(const f32x4*)(a.in[I_HGGN] + jj_layer * 128 + ovc * 16 + 4 * i);
        LBAR();
        unsigned q2[8], k2[8]; u32x4 va, vb;
        const int vsp = tid & 31, vvc = tid >> 5;
#define HG_LOAD_KV(R0) do { _Pragma("unroll") for (int j = 0; j < 8; ++j) k2[j] = *(const unsigned*)(BIG + ((R0) + 8 * w + j) * FF + 1024 + h * 128 + 2 * lane); \
            va = *(const u32x4*)(BIG + ((R0) + 2 * vsp) * FF + 2048 + h * 128 + vvc * 8); vb = *(const u32x4*)(BIG + ((R0) + 2 * vsp + 1) * FF + 2048 + h * 128 + vvc * 8); } while (0)
#define HG_LOAD_Q(R0) do { _Pragma("unroll") for (int j = 0; j < 8; ++j) q2[j] = *(const unsigned*)(BIG + ((R0) + 8 * w + j) * FF + h * 128 + 2 * lane); } while (0)
        HG_LOAD_KV(rowbase);
        if (n_start == 0) HG_LOAD_Q(rowbase);
        for (int n = 0; n < n_end; ++n) {
            const bool full = n >= n_start;
            const size_t r0 = rowbase + (size_t)n * 64;
            u32x4 g0, g1;
            if (full) { g0 = *(const u32x4*)(BIG + (r0 + otok) * FF + 3072 + h * 128 + ovc * 16); g1 = *(const u32x4*)(BIG + (r0 + otok) * FF + 3072 + h * 128 + ovc * 16 + 8); }
            {
                const unsigned vaw[4] = {va.x, va.y, va.z, va.w}, vbw[4] = {vb.x, vb.y, vb.z, vb.w};
#pragma unroll
                for (int i = 0; i < 4; ++i) { const unsigned lo2 = (vaw[i] & 0xffffu) | (vbw[i] << 16), hi2 = (vaw[i] >> 16) | (vbw[i] & 0xffff0000u);
                    *(LAS unsigned*)(VT + (vvc * 8 + 2 * i) * 72 + 2 * vsp) = lo2; *(LAS unsigned*)(VT + (vvc * 8 + 2 * i + 1) * 72 + 2 * vsp) = hi2; }
            }
            float ec[2][8], kk[2][8];
            { float p0 = 1.f, p1 = 1.f;
#pragma unroll
                for (int j = 0; j < 8; ++j) { kk[0][j] = h_lo(k2[j]); kk[1][j] = h_hi(k2[j]); p0 *= (1.0f - kk[0][j]); p1 *= (1.0f - kk[1][j]); ec[0][j] = p0; ec[1][j] = p1; }
                *(LAS f32x2*)(ET + w * 128 + 2 * lane) = (f32x2){p0, p1}; }
            LBAR();
            float es[2] = {1.f, 1.f}, el[2];
            { float r0p = 1.f, r1p = 1.f;
#pragma unroll
                for (int ww = 0; ww < 8; ++ww) { const f32x2 e = *(const LAS f32x2*)(ET + ww * 128 + 2 * lane); if (ww == w) { es[0] = r0p; es[1] = r1p; } r0p *= e.x; r1p *= e.y; }
                el[0] = r0p; el[1] = r1p; }
            if (w == 0) *(LAS f32x2*)(EL + 2 * lane) = (f32x2){el[0], el[1]};
            {
                unsigned khw[2][4];
#pragma unroll
                for (int j = 0; j < 8; ++j) {
                    const float e0 = fmaxf(es[0] * ec[0][j], 1e-30f), e1 = fmaxf(es[1] * ec[1][j], 1e-30f);
                    const float i0 = __builtin_amdgcn_rcpf(e0), i1 = __builtin_amdgcn_rcpf(e1);
                    const float ka = kk[0][j] * i0, kb = kk[1][j] * i1;
                    if (full) { const float qa = bf_lo(q2[j]) * e0, qb = bf_hi(q2[j]) * e1;
                        *(LAS unsigned*)(QT + (8 * w + j) * 136 + 2 * lane) = cvt_pk_bf16(qa, qb);
                        *(LAS unsigned*)(KT + (8 * w + j) * 136 + 2 * lane) = cvt_pk_bf16(ka, kb); }
                    const float ha = ka * el[0], hb = kb * el[1];
                    if (j & 1) { khw[0][j >> 1] = cvt_pk_bf16(ec[0][j - 1], ha); khw[1][j >> 1] = cvt_pk_bf16(ec[1][j - 1], hb); }
                    else { ec[0][j] = ha; ec[1][j] = hb; }
                }
                *(LAS u32x4*)(KH + (2 * lane) * 72 + 8 * w) = (u32x4){khw[0][0], khw[0][1], khw[0][2], khw[0][3]};
                *(LAS u32x4*)(KH + (2 * lane + 1) * 72 + 8 * w) = (u32x4){khw[1][0], khw[1][1], khw[1][2], khw[1][3]};
            }
            LBAR();
            if (n + 1 < n_end) { HG_LOAD_KV(r0 + 64); if (n + 1 >= n_start) HG_LOAD_Q(r0 + 64); }
            f32x4 oacc[4];
            if (full) {
                const int tb = w >> 1;
#pragma unroll
                for (int x = 0; x < 2; ++x) { const int ss = 2 * (w & 1) + x; f32x4 c = (f32x4){0.f, 0.f, 0.f, 0.f};
                    if (ss <= tb) {
#pragma unroll
                        for (int ks = 0; ks < 4; ++ks) { const bf16x8 kf = *(const LAS bf16x8*)(KT + (16 * ss + lo) * 136 + ks * 32 + fq * 8), qf = *(const LAS bf16x8*)(QT + (16 * tb + lo) * 136 + ks * 32 + fq * 8);
                            c = __builtin_amdgcn_mfma_f32_16x16x32_bf16(kf, qf, c, 0, 0, 0); } }
                    const int tq = 16 * tb + lo, s0 = 16 * ss + 4 * fq;
                    float m[4];
#pragma unroll
                    for (int e = 0; e < 4; ++e) m[e] = (s0 + e <= tq) ? c[e] : 0.f;
                    *(LAS u32x2*)(AM + tq * 72 + s0) = (u32x2){cvt_pk_bf16(m[0], m[1]), cvt_pk_bf16(m[2], m[3])}; }
                LBAR();
                const int tb2 = w & 3, vh = w >> 2;
                bf16x8 af[2], qf[4];
#pragma unroll
                for (int ks = 0; ks < 2; ++ks) af[ks] = *(const LAS bf16x8*)(AM + (16 * tb2 + lo) * 72 + ks * 32 + fq * 8);
#pragma unroll
                for (int ks = 0; ks < 4; ++ks) qf[ks] = *(const LAS bf16x8*)(QT + (16 * tb2 + lo) * 136 + ks * 32 + fq * 8);
#pragma unroll
                for (int x = 0; x < 4; ++x) { const int vt = 4 * vh + x; f32x4 c = (f32x4){0.f, 0.f, 0.f, 0.f};
#pragma unroll
                    for (int ks = 0; ks < 2; ++ks) { if (ks == 0 || tb2 >= 2) { const bf16x8 vf = *(const LAS bf16x8*)(VT + (16 * vt + lo) * 72 + ks * 32 + fq * 8); c = __builtin_amdgcn_mfma_f32_16x16x32_bf16(af[ks], vf, c, 0, 0, 0); } }
#pragma unroll
                    for (int ks = 0; ks < 4; ++ks) { const bf16x8 sf = *(const LAS bf16x8*)(ST + (16 * vt + lo) * 136 + ks * 32 + fq * 8); c = __builtin_amdgcn_mfma_f32_16x16x32_bf16(qf[ks], sf, c, 0, 0, 0); }
                    oacc[x] = c; }
            }
            {
                const f32x4 dec = *(const LAS f32x4*)(EL + 16 * w + 4 * fq);
                bf16x8 kf[2];
#pragma unroll
                for (int ks = 0; ks < 2; ++ks) kf[ks] = *(const LAS bf16x8*)(KH + (16 * w + lo) * 72 + ks * 32 + fq * 8);
#pragma unroll
                for (int vt = 0; vt < 8; ++vt) { f32x4 c = Sacc[vt] * dec;
#pragma unroll
                    for (int ks = 0; ks < 2; ++ks) { const bf16x8 vf = *(const LAS bf16x8*)(VT + (16 * vt + lo) * 72 + ks * 32 + fq * 8); c = __builtin_amdgcn_mfma_f32_16x16x32_bf16(kf[ks], vf, c, 0, 0, 0); }
                    Sacc[vt] = c; }
            }
            LBAR();
            if (n + 1 >= n_start) {
#pragma unroll
                for (int vt = 0; vt < 8; ++vt) *(LAS u32x2*)(ST + (16 * vt + lo) * 136 + 16 * w + 4 * fq) = (u32x2){cvt_pk_bf16(Sacc[vt][0], Sacc[vt][1]), cvt_pk_bf16(Sacc[vt][2], Sacc[vt][3])};
            }
            if (full) {
                const int tb2 = w & 3, vh = w >> 2;
#pragma unroll
                for (int x = 0; x < 4; ++x)
#pragma unroll
                    for (int e = 0; e < 4; ++e) OB[(16 * tb2 + 4 * fq + e) * 132 + 16 * (4 * vh + x) + lo] = oacc[x][e];
                LBAR();
                f32x4 ov[4]; float ss = 0.f;
#pragma unroll
                for (int i = 0; i < 4; ++i) { ov[i] = *(const LAS f32x4*)(OB + otok * 132 + ovc * 16 + 4 * i); ss += (ov[i][0] * ov[i][0] + ov[i][1] * ov[i][1]) + (ov[i][2] * ov[i][2] + ov[i][3] * ov[i][3]); }
                ss += __shfl_xor(ss, 1); ss += __shfl_xor(ss, 2); ss += __shfl_xor(ss, 4);
                const float rs = rsqrtf(ss * (1.0f / 128.0f) + GNORM_EPS);
                const unsigned gwd[8] = {g0.x, g0.y, g0.z, g0.w, g1.x, g1.y, g1.z, g1.w};
                unsigned ow[8];
#pragma unroll
                for (int i = 0; i < 4; ++i) { const f32x4 y = ov[i] * rs * gw[i];
                    ow[2 * i] = cvt_pk_bf16(y[0] * bf_lo(gwd[2 * i]), y[1] * bf_hi(gwd[2 * i])); ow[2 * i + 1] = cvt_pk_bf16(y[2] * bf_lo(gwd[2 * i + 1]), y[3] * bf_hi(gwd[2 * i + 1])); }
                bf16_t* op = A2 + (r0 + otok) * D + h * 128 + ovc * 16;
                st16_wt(op, (u32x4){ow[0], ow[1], ow[2], ow[3]}); st16_wt(op + 8, (u32x4){ow[4], ow[5], ow[6], ow[7]});
                LBAR();
            }
        }
        LBAR();
    }
#undef HG_LOAD_KV
#undef HG_LOAD_Q
}

#define XB_TMO      128
#define XB_XCNT(j)  (256  + 64 * (j))
#define XB_XSUB(j)  (1280 + 64 * (j))
#define XB_XGEN(j)  (2304 + 64 * (j))
#define XB_TOP      3328
#define XB_TOPGEN   3392
#define XCD_BAR_WORDS 3456
#define XB_SPIN_CAP (1u << 18)

__device__ __forceinline__ unsigned xb_ld(unsigned* p)              { return __hip_atomic_load(p, __ATOMIC_RELAXED, __HIP_MEMORY_SCOPE_AGENT); }
__device__ __forceinline__ unsigned xb_add(unsigned* p, unsigned v) { return __hip_atomic_fetch_add(p, v, __ATOMIC_RELAXED, __HIP_MEMORY_SCOPE_AGENT); }
__device__ __forceinline__ unsigned xb_xcc_id() { return (unsigned)__builtin_amdgcn_s_getreg((3 << 11) | 20) & 0xFu; }
#define XB_SPIN(cond, bar) do { unsigned _sp = 0; while (cond) { __builtin_amdgcn_s_sleep(1); \
    if ((++_sp & 255u) == 0u) { if (xb_ld(&(bar)[XB_TMO])) break; if (_sp > XB_SPIN_CAP) { atomicAdd(&(bar)[XB_TMO], 1u); break; } } } } while (0)

struct XcdBarrier {
    unsigned* bar; unsigned x;
    volatile LAS unsigned* st;
};

__device__ __forceinline__ XcdBarrier xcd_barrier_post(unsigned* bar, volatile LAS unsigned* st) {
    XcdBarrier b; b.bar = bar; b.x = xb_xcc_id(); b.st = st;
    if (threadIdx.x == 0) (void)xb_add(&bar[XB_XCNT(b.x)], 1u);
    return b;
}
__device__ __forceinline__ void xcd_barrier_complete(unsigned* bar, unsigned x, unsigned& nloc, unsigned& nx) {
    const unsigned G = gridDim.x * gridDim.y * gridDim.z;
    unsigned sum, cnt, mine, sp = 0u;
    for (;;) {
        sum = 0u; cnt = 0u; mine = 0u;
#pragma unroll
        for (unsigned j = 0; j < 16; ++j) { const unsigned c = xb_ld(&bar[XB_XCNT(j)]); sum += c; cnt += (c > 0u) ? 1u : 0u; mine = (j == x) ? c : mine; }
        if (sum == G) break;
        __builtin_amdgcn_s_sleep(1);
        if ((++sp & 255u) == 0u) { if (xb_ld(&bar[XB_TMO])) break; if (sp > XB_SPIN_CAP) { atomicAdd(&bar[XB_TMO], 1u); break; } }
    }
    nloc = mine > 0u ? mine : 1u; nx = cnt > 0u ? cnt : 1u;
}

__device__ __forceinline__ void xcd_barrier(const XcdBarrier& b) {
    asm volatile("s_waitcnt vmcnt(0)" ::: "memory");
    __syncthreads();
    if (threadIdx.x == 0) {
        unsigned* bar = b.bar;
        __builtin_amdgcn_s_waitcnt(0);
        unsigned nloc = b.st[0], nx = b.st[1];
        if (nloc == 0u) { xcd_barrier_complete(bar, b.x, nloc, nx); b.st[0] = nloc; b.st[1] = nx; }
        const unsigned old = xb_add(&bar[XB_XSUB(b.x)], 1u);
        const unsigned gen = old / nloc;
        if (old + 1u == (gen + 1u) * nloc) {
            __builtin_amdgcn_fence(__ATOMIC_RELEASE, "agent");
            asm volatile("s_waitcnt vmcnt(0)" ::: "memory");
            const unsigned og = xb_add(&bar[XB_TOP], 1u);
            const unsigned tg = og / nx;
            if (og + 1u == (tg + 1u) * nx) xb_add(&bar[XB_TOPGEN], 1u);
            else XB_SPIN(xb_ld(&bar[XB_TOPGEN]) == tg, bar);
            __builtin_amdgcn_fence(__ATOMIC_ACQUIRE, "agent");
            xb_add(&bar[XB_XGEN(b.x)], 1u);
            asm volatile("s_waitcnt vmcnt(0)" ::: "memory");
        } else {
            XB_SPIN(xb_ld(&bar[XB_XGEN(b.x)]) == gen, bar);
            __builtin_amdgcn_fence(__ATOMIC_ACQUIRE, "agent");
            asm volatile("s_waitcnt vmcnt(0)" ::: "memory");
        }
    }
    __syncthreads();
}


#define GRID_SYNC() do { unsigned* _bp = (unsigned*)a.ws; asm volatile("" : "+s"(_bp)); XcdBarrier _xb; _xb.bar = _bp; _xb.x = xb_xcc_id(); _xb.st = (volatile LAS unsigned*)(lds + 131072); xcd_barrier(_xb); } while (0)
__global__ void __launch_bounds__(512, 2) fwd_megakernel(Args a) {
    extern __shared__ __attribute__((aligned(16))) unsigned char lds_raw[];
    LAS unsigned char* lds = (LAS unsigned char*)lds_raw;
    cg::grid_group grid = cg::this_grid();
    const int G = gridDim.x, bx = blockIdx.x;
    const int wv = __builtin_amdgcn_readfirstlane((int)threadIdx.x >> 6);
    const int vcu = (G % 8 == 0) ? (bx % 8) * (G / 8) + bx / 8 : bx;
    unsigned char* ws = a.ws;
    const float* mod = (const float*)(ws + WS_MOD);
    bf16_t* A1 = (bf16_t*)(ws + WS_A1); bf16_t* A2 = (bf16_t*)(ws + WS_A2); bf16_t* BIG = (bf16_t*)(ws + WS_BIG);

    if (threadIdx.x < 2) ((volatile LAS unsigned*)(lds + 131072))[threadIdx.x] = 0u;
    __syncthreads();
    (void)xcd_barrier_post((unsigned*)ws, (volatile LAS unsigned*)(lds + 131072));
    prologue(lds, a, vcu, G, wv);
    if (G > 65535) grid.sync();
    GRID_SYNC();

    const float* xin = a.in[I_X];
    float* SS = (float*)(ws + WS_SS); const float* SHW = (const float*)(ws + WS_SHW); bf16_t* XB = (bf16_t*)(ws + WS_XB); unsigned char* XL = ws + WS_XL;
    norm0_phase(xin, a.in[I_NMIX], mod + 1 * D, A1, SS, vcu, G, wv);
    shw_phase(a, vcu, G, wv);
    GRID_SYNC();
    for (int l = 0; l < DEPTH; ++l) {
        const float* modl = mod + (size_t)l * NB * MODW;
        const int jx = l >> 1;
        if ((l & 1) == 0) {
            { pg8::Gemm g{A1, (const bf16_t*)(ws + W_RGIN) + (size_t)jx * 2048 * D, M, 2048, D}; pg8::StaticOrder S; S.init(M, 2048, G, bx);
              pg8::stage_unit_tables(lds + 131072 + 1024, S, SS, SHW + (size_t)(2 * l) * 8 * 4096, wv);
              pg8::EpiAct<0> E{BIG, 2048, nullptr, lds + 131072 + 1024};
              pg8::gemm_phase<pg8::EpiAct<0>, pg8::StaticOrder, true, true>(lds, g, S, E, wv); }
            GRID_SYNC();
            rg_phase(lds, a, jx, vcu, G, wv);
        } else {
            { pg8::Gemm g{A1, (const bf16_t*)(ws + W_HGIN) + (size_t)jx * FF * D, M, FF, D}; pg8::StaticOrder S; S.init(M, FF, G, bx);
              pg8::stage_unit_tables(lds + 131072 + 1024, S, SS, SHW + (size_t)(2 * l) * 8 * 4096, wv);
              pg8::EpiAct<1> E{BIG, FF, (const float*)(ws + WS_LB) + jx * D, lds + 131072 + 1024};
              pg8::gemm_phase<pg8::EpiAct<1>, pg8::StaticOrder, true, true>(lds, g, S, E, wv); }
            GRID_SYNC();
            hg_phase(lds, a, jx, vcu, G, wv);
        }
        GRID_SYNC();
        { pg8::Gemm g{A2, (l & 1) ? (const bf16_t*)(ws + W_HGOUT) + (size_t)jx * D * D : (const bf16_t*)(ws + W_RGOUT) + (size_t)jx * D * D, M, D, D}; pg8::StaticOrder S; S.init(M, D, G, bx);
          if (l == 0) { pg8::EpiRes<true> E{a.in[I_X], nullptr, nullptr, XB, XL, modl + 2 * D, A1, a.in[I_NMLP] + l * D, modl + 4 * D, SS};
            pg8::gemm_phase<pg8::EpiRes<true>, pg8::StaticOrder, true, true>(lds, g, S, E, wv); }
          else { pg8::EpiRes<false> E{nullptr, XB, XL, XB, XL, modl + 2 * D, A1, a.in[I_NMLP] + l * D, modl + 4 * D, SS};
            pg8::gemm_phase<pg8::EpiRes<false>, pg8::StaticOrder, true, true>(lds, g, S, E, wv); } }
        GRID_SYNC();
        { pg8::Gemm g{A1, (const bf16_t*)(ws + W_W1) + (size_t)l * FF * D, M, FF, D}; pg8::StaticOrder S; S.init(M, FF, G, bx);
          pg8::stage_unit_tables(lds + 131072 + 1024, S, SS, SHW + (size_t)(2 * l + 1) * 8 * 4096, wv);
          pg8::EpiAct<2> E{BIG, FF, nullptr, lds + 131072 + 1024};
          pg8::gemm_phase<pg8::EpiAct<2>, pg8::StaticOrder, true, true>(lds, g, S, E, wv); }
        GRID_SYNC();
        { pg8::Gemm g{BIG, (const bf16_t*)(ws + W_W2) + (size_t)l * D * FF, M, D, FF}; pg8::StaticOrder S; S.init(M, D, G, bx);
          const bool lastl = (l == DEPTH - 1);
          pg8::EpiRes<false> E{nullptr, XB, XL, XB, XL, modl + 5 * D, lastl ? nullptr : A1, a.in[I_NMIX] + (lastl ? 0 : (l + 1) * D), mod + (size_t)(lastl ? 0 : (l + 1)) * NB * MODW + 1 * D, SS};
          pg8::gemm_phase<pg8::EpiRes<false>, pg8::StaticOrder, true, true>(lds, g, S, E, wv); }
        GRID_SYNC();
    }
    final_norm_phase(XB, XL, a.in[I_NFIN], a.out, vcu, G, wv);
}

extern "C" void kernel_launch(void* const* d_in, const int* in_sizes, int n_in, void* d_out, int out_size, void* d_ws, size_t ws_size, hipStream_t stream) {
    static int grid = 0;
    if (grid == 0) {
        if (n_in != 22 || out_size != M * D || ws_size < WS_END) { fprintf(stderr, "kernel_launch: unexpected shapes (n_in %d out %d ws %zu)\n", n_in, out_size, ws_size); grid = -1; return; }
        int dev = 0, cus = 0, per_cu = 0;
        hipGetDevice(&dev);
        hipDeviceGetAttribute(&cus, hipDeviceAttributeMultiprocessorCount, dev);
        hipFuncSetAttribute((const void*)fwd_megakernel, hipFuncAttributeMaxDynamicSharedMemorySize, LDS_BYTES);
        hipOccupancyMaxActiveBlocksPerMultiprocessor(&per_cu, (const void*)fwd_megakernel, 512, LDS_BYTES);
        if (per_cu < 1) { fprintf(stderr, "kernel_launch: occupancy query says %d blocks/CU\n", per_cu); per_cu = 1; }
        (void)hipGetLastError();
        grid = cus;
    }
    if (grid < 0) return;
    (void)hipMemsetAsync(d_ws, 0, 16384, stream);
    Args a{};
    for (int i = 0; i < 22; ++i) a.in[i] = (const float*)d_in[i];
    a.out = (float*)d_out; a.ws = (unsigned char*)d_ws;
    void* args[] = {&a};
    hipError_t e = hipLaunchCooperativeKernel((const void*)fwd_megakernel, dim3(grid), dim3(512), args, LDS_BYTES, stream);
    if (e != hipSuccess) fprintf(stderr, "cooperative launch failed: %s (grid %d)\n", hipGetErrorString(e), grid);
}
```
